# Optimizing an MI355X kernel written in HIP

```python
import jax, jax.numpy as jnp
from jax import lax
import numpy as np

D_MODEL = 2048
BATCH = 16
SEQ = 2048
DEPTH = 1

D_CONV = D_MODEL // 2
CONV_HEADS = 16
CONV_HEAD_DIM = D_CONV // CONV_HEADS
CONV_WIDTH = 3
D_LRU = D_MODEL // 2
LRU_HEADS = 8
LRU_HEAD_DIM = D_LRU // LRU_HEADS
LRU_CONV_WIDTH = 4
LRU_C = 8.0
D_MIX = D_CONV + D_LRU
D_IN = 3 * D_CONV + 2 * D_LRU
N_GROUPS = 8
EXPERTS_PER_GROUP = 8
N_EXPERTS = N_GROUPS * EXPERTS_PER_GROUP
TOP_K = 2
D_EXPERT = D_MODEL // 4
EXPERT_BLOCK = 128
EPS = 1e-6

kernel_name = "hybrid_conv_rglru_hiermoe_adaln"


def rms_normalize(x):
    xf = x.astype(jnp.float32)
    return xf * lax.rsqrt(jnp.mean(xf * xf, axis=-1, keepdims=True) + EPS)


def rmsnorm(x, g):
    return (rms_normalize(x) * g.astype(jnp.float32)).astype(x.dtype)


def modulated_rmsnorm(x, g, shift, scale):
    y = rms_normalize(x) * g.astype(jnp.float32)
    y = y * (1.0 + scale.astype(jnp.float32)[:, None, :]) + shift.astype(jnp.float32)[:, None, :]
    return y.astype(x.dtype)


def head_rmsnorm(y, g, n_heads, head_dim):
    b, s, _ = y.shape
    yn = rms_normalize(y.reshape(b, s, n_heads, head_dim)).reshape(b, s, n_heads * head_dim)
    return (yn * g.astype(jnp.float32)).astype(y.dtype)


def causal_depthwise_conv(u, w):
    k, ch = w.shape
    return lax.conv_general_dilated(
        u, w[:, None, :].astype(u.dtype), window_strides=(1,), padding=[(k - 1, 0)],
        dimension_numbers=("NWC", "WIO", "NWC"), feature_group_count=ch)


def rg_lru(xb, w_a, b_a, w_x, b_x, lam):
    bsz, s, dm = xb.shape
    xh = xb.reshape(bsz, s, LRU_HEADS, LRU_HEAD_DIM)
    r = jax.nn.sigmoid((jnp.einsum("bshi,hij->bshj", xh, w_a).reshape(bsz, s, dm) + b_a).astype(jnp.float32))
    i = jax.nn.sigmoid((jnp.einsum("bshi,hij->bshj", xh, w_x).reshape(bsz, s, dm) + b_x).astype(jnp.float32))
    log_a = -LRU_C * r * jax.nn.softplus(-lam.astype(jnp.float32))
    a = jnp.exp(log_a)
    mult = jnp.sqrt(-jnp.expm1(2.0 * log_a))
    u = mult * i * xb.astype(jnp.float32)

    def step(h, inp):
        a_t, u_t = inp
        h = a_t * h + u_t
        return h, h

    h0 = jnp.zeros((bsz, dm), jnp.float32)
    _, hs = lax.scan(step, h0, (jnp.swapaxes(a, 0, 1), jnp.swapaxes(u, 0, 1)))
    return jnp.swapaxes(hs, 0, 1).astype(xb.dtype)


def token_mix(h, w_in, conv3_w, conv4_w, conv4_b, lru_w_a, lru_b_a, lru_w_x, lru_b_x, lru_lambda,
              head_norm_conv_g, head_norm_lru_g, w_out):
    proj = h @ w_in
    b_a, c_a, x_a, g_b, x_b = jnp.split(
        proj, [D_CONV, 2 * D_CONV, 3 * D_CONV, 3 * D_CONV + D_LRU], axis=-1)
    y_a = b_a * causal_depthwise_conv(c_a * x_a, conv3_w)
    x_b = causal_depthwise_conv(x_b, conv4_w) + conv4_b.astype(x_b.dtype)
    y_b = rg_lru(x_b, lru_w_a, lru_b_a, lru_w_x, lru_b_x, lru_lambda) * jax.nn.gelu(g_b)
    y = jnp.concatenate([
        head_rmsnorm(y_a, head_norm_conv_g, CONV_HEADS, CONV_HEAD_DIM),
        head_rmsnorm(y_b, head_norm_lru_g, LRU_HEADS, LRU_HEAD_DIM)], axis=-1)
    return y @ w_out


def hier_moe(h, route_w_group, route_b_group, route_w_expert, route_b_expert, w_e_gate, w_e_up, w_e_down):
    n, d = h.shape
    group_logits = (h @ route_w_group).astype(jnp.float32) + route_b_group.astype(jnp.float32)
    group_probs = jax.nn.softmax(group_logits, axis=-1)
    p_top, g_top = lax.top_k(group_probs, 1)
    p_g, g_idx = p_top[:, 0], g_top[:, 0]
    all_logits = jnp.einsum("nd,gde->nge", h, route_w_expert).astype(jnp.float32) \
        + route_b_expert.astype(jnp.float32)
    in_group = jnp.take_along_axis(all_logits, g_idx[:, None, None], axis=1)[:, 0, :]
    top_vals, top_idx = lax.top_k(in_group, TOP_K)
    weights = (p_g[:, None] * jax.nn.softmax(top_vals, axis=-1)).astype(h.dtype)
    expert_id = g_idx[:, None] * EXPERTS_PER_GROUP + top_idx

    n_assign = n * TOP_K
    eid = expert_id.reshape(-1).astype(jnp.int32)
    tok = jnp.repeat(jnp.arange(n, dtype=jnp.int32), TOP_K)
    wts = weights.reshape(-1)
    order = jnp.argsort(eid)
    s_eid, s_tok, s_w = eid[order], tok[order], wts[order]
    counts = jnp.bincount(eid, length=N_EXPERTS)
    starts = jnp.cumsum(counts) - counts
    padded = ((counts + EXPERT_BLOCK - 1) // EXPERT_BLOCK) * EXPERT_BLOCK
    padded_ends = jnp.cumsum(padded)
    padded_starts = padded_ends - padded
    dest = padded_starts[s_eid] + (jnp.arange(n_assign, dtype=jnp.int32) - starts[s_eid])
    n_rows = -(-n_assign // EXPERT_BLOCK) * EXPERT_BLOCK + N_EXPERTS * EXPERT_BLOCK
    n_blocks = n_rows // EXPERT_BLOCK
    row_tok = jnp.full((n_rows,), n, jnp.int32).at[dest].set(s_tok)
    row_w = jnp.zeros((n_rows,), h.dtype).at[dest].set(s_w)
    block_expert = jnp.minimum(
        jnp.searchsorted(padded_ends, jnp.arange(n_blocks, dtype=jnp.int32) * EXPERT_BLOCK, side="right"),
        N_EXPERTS - 1)
    h_ext = jnp.concatenate([h, jnp.zeros((1, d), h.dtype)], axis=0)
    xb = h_ext[row_tok].reshape(n_blocks, EXPERT_BLOCK, d)

    def expert_block(args):
        x_blk, e = args
        return (jax.nn.silu(x_blk @ w_e_gate[e]) * (x_blk @ w_e_up[e])) @ w_e_down[e]

    yb = lax.map(expert_block, (xb, block_expert)).reshape(n_rows, d)
    y = jnp.zeros((n + 1, d), h.dtype).at[row_tok].add(yb * row_w[:, None])
    return y[:n]


def setup_inputs(seed: int = 0) -> dict:
    key = jax.random.key(seed)
    ks = jax.random.split(key, 32)
    f32 = jnp.float32
    nrm = lambda k, shape, scale: jax.random.normal(k, shape, f32) * scale
    L = DEPTH
    u = jax.random.uniform(ks[14], (L, D_LRU), f32, minval=0.9, maxval=0.999)
    s = u ** (1.0 / LRU_C)
    lru_lambda = jnp.log(s) - jnp.log1p(-s)
    return {
        "x": nrm(ks[0], (BATCH, SEQ, D_MODEL), 1.0),
        "c": nrm(ks[1], (BATCH, D_MODEL), 1.0),
        "ada_w": nrm(ks[2], (L, D_MODEL, 6 * D_MODEL), 0.5 * D_MODEL ** -0.5),
        "ada_b": nrm(ks[3], (L, 6 * D_MODEL), 0.02),
        "norm1_g": 1.0 + nrm(ks[4], (L, D_MODEL), 0.02),
        "w_in": nrm(ks[5], (L, D_MODEL, D_IN), D_MODEL ** -0.5),
        "conv3_w": nrm(ks[6], (L, CONV_WIDTH, D_CONV), CONV_WIDTH ** -0.5),
        "conv4_w": nrm(ks[7], (L, LRU_CONV_WIDTH, D_LRU), LRU_CONV_WIDTH ** -0.5),
        "conv4_b": nrm(ks[8], (L, D_LRU), 0.02),
        "lru_w_a": nrm(ks[9], (L, LRU_HEADS, LRU_HEAD_DIM, LRU_HEAD_DIM), LRU_HEAD_DIM ** -0.5),
        "lru_b_a": nrm(ks[10], (L, D_LRU), 0.02),
        "lru_w_x": nrm(ks[11], (L, LRU_HEADS, LRU_HEAD_DIM, LRU_HEAD_DIM), LRU_HEAD_DIM ** -0.5),
        "lru_b_x": nrm(ks[12], (L, D_LRU), 0.02),
        "lru_lambda": lru_lambda,
        "head_norm_conv_g": 1.0 + nrm(ks[15], (L, D_CONV), 0.02),
        "head_norm_lru_g": 1.0 + nrm(ks[16], (L, D_LRU), 0.02),
        "w_out": nrm(ks[17], (L, D_MIX, D_MODEL), D_MIX ** -0.5),
        "norm2_g": 1.0 + nrm(ks[18], (L, D_MODEL), 0.02),
        "route_w_group": nrm(ks[19], (L, D_MODEL, N_GROUPS), D_MODEL ** -0.5),
        "route_b_group": nrm(ks[20], (L, N_GROUPS), 0.01),
        "route_w_expert": nrm(ks[21], (L, N_GROUPS, D_MODEL, EXPERTS_PER_GROUP), D_MODEL ** -0.5),
        "route_b_expert": nrm(ks[22], (L, N_GROUPS, EXPERTS_PER_GROUP), 0.01),
        "w_e_gate": nrm(ks[23], (L, N_EXPERTS, D_MODEL, D_EXPERT), D_MODEL ** -0.5),
        "w_e_up": nrm(ks[24], (L, N_EXPERTS, D_MODEL, D_EXPERT), D_MODEL ** -0.5),
        "w_e_down": nrm(ks[25], (L, N_EXPERTS, D_EXPERT, D_MODEL), D_EXPERT ** -0.5),
        "final_norm_g": 1.0 + nrm(ks[26], (D_MODEL,), 0.02),
    }


def reference(x, c, ada_w, ada_b, norm1_g, w_in, conv3_w, conv4_w, conv4_b, lru_w_a, lru_b_a,
              lru_w_x, lru_b_x, lru_lambda, head_norm_conv_g, head_norm_lru_g, w_out, norm2_g,
              route_w_group, route_b_group, route_w_expert, route_b_expert,
              w_e_gate, w_e_up, w_e_down, final_norm_g):
    bsz, s, d = x.shape
    for l in range(DEPTH):
        mod = jax.nn.silu(c) @ ada_w[l] + ada_b[l]
        sh1, sc1, g1, sh2, sc2, g2 = jnp.split(mod, 6, axis=-1)
        h = modulated_rmsnorm(x, norm1_g[l], sh1, sc1)
        mix = token_mix(h, w_in[l], conv3_w[l], conv4_w[l], conv4_b[l], lru_w_a[l], lru_b_a[l],
                        lru_w_x[l], lru_b_x[l], lru_lambda[l], head_norm_conv_g[l],
                        head_norm_lru_g[l], w_out[l])
        x = x + g1[:, None, :] * mix
        h = modulated_rmsnorm(x, norm2_g[l], sh2, sc2)
        y = hier_moe(h.reshape(bsz * s, d), route_w_group[l], route_b_group[l], route_w_expert[l],
                     route_b_expert[l], w_e_gate[l], w_e_up[l], w_e_down[l]).reshape(bsz, s, d)
        x = x + g2[:, None, :] * y
    return rmsnorm(x, final_norm_g)
```

```cpp
#include <hip/hip_runtime.h>
#include <cstdio>
#include <cstdint>

#ifndef MK_N_LAUNCHES
#define MK_N_LAUNCHES 9
#endif

constexpr int D = 2048, NB = 16, SEQ = 2048, M = NB * SEQ;
constexpr int DC = 1024, DL = 1024, DIN = 5120;
constexpr int CONV_HD = 64, LRU_HEADS = 8, LRU_HD = 128;
constexpr int NE = 64, NGRP = 8, EPG = 8, DE = 512;
constexpr int NRC = 80;
constexpr float EPS = 1e-6f;
constexpr int MT_MAX = (2 * M) / 256 + NE;
constexpr int LISTCAP = M;

constexpr size_t MiB = 1u << 20;
constexpr size_t WS_CTL = 0, CTL_ZERO_BYTES = 1 * MiB;
constexpr size_t WS_MOD = 1 * MiB;
constexpr size_t WS_ROUT = 2 * MiB;
constexpr size_t WS_WR = 3 * MiB;
constexpr size_t WS_LTOK = 4 * MiB;
constexpr size_t WS_LW = 12 * MiB;
constexpr size_t WS_WIN = 20 * MiB;
constexpr size_t WS_WOUT = 40 * MiB;
constexpr size_t WS_WGU = 48 * MiB;
constexpr size_t WS_WD = 304 * MiB;
constexpr size_t WS_XN = 432 * MiB;
constexpr size_t WS_PROJ = 560 * MiB;
constexpr size_t WS_Y = 880 * MiB;
constexpr size_t WS_END = 1008 * MiB;
constexpr int CW_BAR = 4096;
constexpr int CW_CNT = 16384;

constexpr int RING_BYTES = 131072;
constexpr int LDSCTL_OFF = 143360;
constexpr int LDS_BYTES = 147456;
constexpr int MISC_OFF = LDSCTL_OFF;
constexpr int TAB_OFF = LDSCTL_OFF + 256;
constexpr int NWAVES = 8;

#define GAS __attribute__((address_space(1)))
#define LAS __attribute__((address_space(3)))
typedef unsigned short bf16;
typedef unsigned v4u __attribute__((ext_vector_type(4)));
typedef unsigned v2u __attribute__((ext_vector_type(2)));
typedef float f32x4 __attribute__((ext_vector_type(4)));
typedef float f32x2 __attribute__((ext_vector_type(2)));
typedef float f32x16 __attribute__((ext_vector_type(16)));
typedef short bf16x8 __attribute__((ext_vector_type(8)));
typedef __bf16 bf16x2_t __attribute__((ext_vector_type(2)));
typedef GAS unsigned gu32;
#define RLX_AGENT __ATOMIC_RELAXED, __HIP_MEMORY_SCOPE_AGENT
#define LDS_WAIT() asm volatile("s_waitcnt lgkmcnt(0)" ::: "memory")
#define VM_WAIT() asm volatile("s_waitcnt vmcnt(0)" ::: "memory")

__device__ __forceinline__ unsigned cvtpk(float lo, float hi) { f32x2 v = {lo, hi}; bf16x2_t b = __builtin_convertvector(v, bf16x2_t); return __builtin_bit_cast(unsigned, b); }
__device__ __forceinline__ float bf_lo(unsigned w) { return __builtin_bit_cast(float, w << 16); }
__device__ __forceinline__ float bf_hi(unsigned w) { return __builtin_bit_cast(float, w & 0xffff0000u); }
__device__ __forceinline__ float bf2f(bf16 b) { return __builtin_bit_cast(float, ((unsigned)b) << 16); }
__device__ __forceinline__ float fast_rcp(float x) { return __builtin_amdgcn_rcpf(x); }
__device__ __forceinline__ float fast_exp(float x) { return __builtin_amdgcn_exp2f(x * 1.44269504089f); }
__device__ __forceinline__ float fast_sqrt(float x) { return __builtin_amdgcn_sqrtf(x); }
__device__ __forceinline__ float fast_rsq(float x) { return __builtin_amdgcn_rsqf(x); }
__device__ __forceinline__ float sigmoidf_(float x) { return fast_rcp(1.0f + fast_exp(-x)); }
__device__ __forceinline__ float wave_sum(float v) {
#pragma unroll
    for (int o = 1; o < 64; o <<= 1) v += __shfl_xor(v, o);
    return v;
}

namespace pg8 {
constexpr int BM = 256, BK = 64, HALF = 128, HTB = HALF * BK * 2, STAGE_BYTES = 8 * HTB, NXCD = 8, WGM = 8;
__host__ __device__ __forceinline__ int lds_byte(int r, int c) { const int st = (r >> 4) * 2 + (c >> 5), rr = r & 15, cc = c & 31, ob = rr * 64 + cc * 2; return st * 1024 + (ob ^ (((ob >> 9) & 1) << 5)); }
__host__ __device__ __forceinline__ void stage_rc(int b, int& R, int& C) { const int st = b / 1024, sb = b % 1024, swz = sb ^ (((sb >> 9) & 1) << 5); R = (st >> 1) * 16 + swz / 64; C = (st & 1) * 32 + (swz % 64) / 2; }
__host__ __device__ __forceinline__ int perm32(int rho) { const int n = rho >> 4, i = rho & 15; return 8 * (i >> 2) + 4 * n + (i & 3); }

struct Unit { int pm, pn, e, r0, cnt, nt; };
struct Gemm { const bf16* A; const bf16* Bt; int K; };

struct StaticOrder {
    int nM, nN, nwg, G, c;
    __device__ void init(int M_, int N_, int G_, int c_) { nM = M_ / BM; nN = N_ / BM; nwg = nM * nN; G = G_; c = c_; }
    __device__ __forceinline__ bool next(int i, Unit& u) const {
        const long L = (long)i * G + c; if (L >= nwg) return false;
        int wgid = (int)L; { const int q = nwg / NXCD, r = nwg % NXCD, xcd = wgid % NXCD, off = wgid / NXCD; wgid = (xcd < r ? xcd * (q + 1) : r * (q + 1) + (xcd - r) * q) + off; }
        const int nig = WGM * nN, gid = wgid / nig, fm = gid * WGM, gsz = (nM - fm) < WGM ? (nM - fm) : WGM;
        u.pm = fm + ((wgid % nig) % gsz); u.pn = (wgid % nig) / gsz; u.e = 0; u.r0 = 0; u.cnt = 0; u.nt = 0; return true;
    }
    __device__ __forceinline__ void a_off(const Unit&, const int (&R)[2], const int (&C)[2], int K, unsigned (&o)[2][2]) const {
#pragma unroll
        for (int h = 0; h < 2; ++h)
#pragma unroll
            for (int i = 0; i < 2; ++i) o[h][i] = (unsigned)((h * HALF + R[i]) * K + C[i]) * 2u;
    }
    __device__ __forceinline__ const char* a_base(const Gemm& g, const Unit& u) const { return (const char*)g.A + (size_t)u.pm * ((size_t)BM * g.K * 2); }
};
template <int NT, bool GATHER> struct GroupedOrder {
    const LAS int* tstart; const LAS int* texp; const int* ltok; const unsigned* cnt; int G, vcu;
    __device__ __forceinline__ bool next(int i, Unit& u) const {
        const int total = tstart[NE] * NT;
        const int gx = G >> 3, x = vcu / gx, j = vcu % gx;
        const int per = (total + 7) >> 3, q = x * per + j + i * gx;
        if (j + i * gx >= per || q >= total) return false;
        const int mt = q / NT; u.nt = q % NT; u.pm = mt;
        const int e = __builtin_amdgcn_readfirstlane(texp[mt]); u.e = e; u.pn = e * NT + u.nt;
        u.r0 = (mt - __builtin_amdgcn_readfirstlane(tstart[e])) * BM;
        u.cnt = (int)__builtin_amdgcn_readfirstlane(__hip_atomic_load(cnt + 64 * e, RLX_AGENT));
        return true;
    }
    __device__ __forceinline__ void a_off(const Unit& u, const int (&R)[2], const int (&C)[2], int K, unsigned (&o)[2][2]) const {
#pragma unroll
        for (int h = 0; h < 2; ++h)
#pragma unroll
            for (int i = 0; i < 2; ++i) {
                if (GATHER) { const int rie = u.r0 + h * HALF + R[i]; const int tok = rie < u.cnt ? ltok[(size_t)u.e * LISTCAP + rie] : 0; o[h][i] = (unsigned)(tok * K + C[i]) * 2u; }
                else o[h][i] = (unsigned)((h * HALF + R[i]) * K + C[i]) * 2u;
            }
    }
    __device__ __forceinline__ const char* a_base(const Gemm& g, const Unit& u) const { return GATHER ? (const char*)g.A : (const char*)g.A + (size_t)u.pm * ((size_t)BM * g.K * 2); }
};

struct EpiBf16 {
    static constexpr bool PERM = true;
    bf16* O; int ldc;
    __device__ __forceinline__ void operator()(const f32x4 (&acc)[2][2][4][2], const Unit& u, int wr, int wc, int fr, int fq) const {
        const int row0 = u.pm * BM + wr * 64 + fr, col0 = u.pn * BM + wc * 32 + 8 * fq;
#pragma unroll
        for (int ai = 0; ai < 2; ++ai)
#pragma unroll
            for (int m = 0; m < 4; ++m) { bf16* rowp = O + (size_t)(row0 + ai * HALF + m * 16) * ldc + col0;
#pragma unroll
                for (int bj = 0; bj < 2; ++bj) { const f32x4 v0 = acc[ai][bj][m][0], v1 = acc[ai][bj][m][1];
                    v4u w; w.x = cvtpk(v0[0], v0[1]); w.y = cvtpk(v0[2], v0[3]); w.z = cvtpk(v1[0], v1[1]); w.w = cvtpk(v1[2], v1[3]);
                    *(v4u*)(rowp + bj * HALF) = w; } }
    }
};
struct EpiRes {
    static constexpr bool PERM = false;
    const float* x; float* out; const float* gate;
    __device__ __forceinline__ void operator()(const f32x4 (&acc)[2][2][4][2], const Unit& u, int wr, int wc, int fr, int fq) const {
        const int row0 = u.pm * BM + wr * 64 + fr, col0 = u.pn * BM + wc * 32 + 4 * fq;
        const float* gp = gate + (size_t)((u.pm * BM) / SEQ) * (6 * D) + col0;
        f32x4 gv[2][2];
#pragma unroll
        for (int bj = 0; bj < 2; ++bj)
#pragma unroll
            for (int n = 0; n < 2; ++n) gv[bj][n] = *(const f32x4*)(gp + bj * HALF + n * 16);
#pragma unroll
        for (int ai = 0; ai < 2; ++ai)
#pragma unroll
            for (int m = 0; m < 4; ++m) { const size_t off = (size_t)(row0 + ai * HALF + m * 16) * D + col0;
#pragma unroll
                for (int bj = 0; bj < 2; ++bj)
#pragma unroll
                    for (int n = 0; n < 2; ++n) { const f32x4 xs = *(const f32x4*)(x + off + bj * HALF + n * 16);
                        *(f32x4*)(out + off + bj * HALF + n * 16) = xs + gv[bj][n] * acc[ai][bj][m][n]; }
                asm volatile("" ::: "memory"); }
    }
};
struct EpiSwiGLU {
    static constexpr bool PERM = true;
    bf16* H;
    __device__ __forceinline__ void operator()(const f32x4 (&acc)[2][2][4][2], const Unit& u, int wr, int wc, int fr, int fq) const {
        const int row0 = u.pm * BM + wr * 64 + fr, col0 = u.nt * HALF + wc * 32 + 8 * fq;
#pragma unroll
        for (int ai = 0; ai < 2; ++ai)
#pragma unroll
            for (int m = 0; m < 4; ++m) { bf16* rowp = H + (size_t)(row0 + ai * HALF + m * 16) * DE + col0;
                float h[8];
#pragma unroll
                for (int n = 0; n < 2; ++n)
#pragma unroll
                    for (int j = 0; j < 4; ++j) { const float g = acc[ai][0][m][n][j], up = acc[ai][1][m][n][j]; h[n * 4 + j] = g * sigmoidf_(g) * up; }
                v4u w; w.x = cvtpk(h[0], h[1]); w.y = cvtpk(h[2], h[3]); w.z = cvtpk(h[4], h[5]); w.w = cvtpk(h[6], h[7]);
                *(v4u*)rowp = w; }
    }
};
struct EpiScale {
    static constexpr bool PERM = true;
    bf16* O; const float* lw;
    __device__ __forceinline__ void operator()(const f32x4 (&acc)[2][2][4][2], const Unit& u, int wr, int wc, int fr, int fq) const {
        const int rt0 = wr * 64 + fr, col0 = u.nt * BM + wc * 32 + 8 * fq;
        float wv[2][4];
#pragma unroll
        for (int ai = 0; ai < 2; ++ai)
#pragma unroll
            for (int m = 0; m < 4; ++m) { const int rie = u.r0 + rt0 + ai * HALF + m * 16; wv[ai][m] = rie < u.cnt ? lw[(size_t)u.e * LISTCAP + rie] : 0.f; }
#pragma unroll
        for (int ai = 0; ai < 2; ++ai)
#pragma unroll
            for (int m = 0; m < 4; ++m) { bf16* rowp = O + (size_t)(u.pm * BM + rt0 + ai * HALF + m * 16) * D + col0; const float s = wv[ai][m];
#pragma unroll
                for (int bj = 0; bj < 2; ++bj) { const f32x4 v0 = acc[ai][bj][m][0] * s, v1 = acc[ai][bj][m][1] * s;
                    v4u w; w.x = cvtpk(v0[0], v0[1]); w.y = cvtpk(v0[2], v0[3]); w.z = cvtpk(v1[0], v1[1]); w.w = cvtpk(v1[2], v1[3]);
                    *(v4u*)(rowp + bj * HALF) = w; } }
    }
};

template <class Epi, class Sched, bool ALIGN_EPI>
__device__ __forceinline__ void gemm_phase(LAS unsigned char* lds, const Gemm g, const Sched& S, const Epi& E) {
    const int tid = threadIdx.x, wid = __builtin_amdgcn_readfirstlane(tid >> 6), lane = tid & 63, wr = wid >> 2, wc = wid & 3, fr = lane & 15, fq = lane >> 4;
    const int K = g.K, nt = K / BK;
    int Rr[2], Cc[2]; unsigned voffB[2];
#pragma unroll
    for (int i = 0; i < 2; ++i) { int R, C; stage_rc(tid * 16 + i * 8192, R, C); const int Rb = Epi::PERM ? ((R & ~31) + perm32(R & 31)) : R; Rr[i] = R; Cc[i] = C; voffB[i] = (unsigned)(Rb * K + C) * 2u; }
    const size_t kstep = (size_t)(BK * 2);
    const size_t hstep = (size_t)HALF * K * 2;
    const size_t tstep = 2 * hstep;
    const unsigned ldsw = (unsigned)wid * 1024u;
    const int aoff = lds_byte(wr * 64 + fr, fq * 8), boff = lds_byte(wc * 32 + fr, fq * 8);
#define PG8_SA(b, h) (((b) * 2 + (h)) * HTB)
#define PG8_SB(b, h) ((4 + (b) * 2 + (h)) * HTB)
#define PG8_STAGE(bufoff, gbase, voff) do { _Pragma("unroll") for (int _i = 0; _i < 2; ++_i) \
        __builtin_amdgcn_global_load_lds((const unsigned*)((const char*)(gbase) + (voff)[_i]), (LAS unsigned*)(lds + (bufoff) + ldsw + _i * 8192), 16, 0, 0); } while (0)
#define PG8_LDA(dst, b, h) do { _Pragma("unroll") for (int m = 0; m < 4; ++m) _Pragma("unroll") for (int k = 0; k < 2; ++k) dst[m][k] = *(const LAS bf16x8*)(lds + PG8_SA(b, h) + aoff + m * 2048 + k * 1024); } while (0)
#define PG8_LDB(dst, b, h) do { _Pragma("unroll") for (int n = 0; n < 2; ++n) _Pragma("unroll") for (int k = 0; k < 2; ++k) dst[n][k] = *(const LAS bf16x8*)(lds + PG8_SB(b, h) + boff + n * 2048 + k * 1024); } while (0)
#define PG8_MMA(ai, bj, At, Bt) do { __builtin_amdgcn_s_setprio(1); _Pragma("unroll") for (int m = 0; m < 4; ++m) _Pragma("unroll") for (int n = 0; n < 2; ++n) _Pragma("unroll") for (int k = 0; k < 2; ++k) \
        acc[ai][bj][m][n] = __builtin_amdgcn_mfma_f32_16x16x32_bf16(Bt[n][k], At[m][k], acc[ai][bj][m][n], 0, 0, 0); __builtin_amdgcn_s_setprio(0); } while (0)
#define PG8_WAIT_V(n) asm volatile("s_waitcnt vmcnt(" #n ")" ::: "memory")
#define PG8_WAIT_L(n) asm volatile("s_waitcnt lgkmcnt(" #n ")" ::: "memory")
#define PG8_BAR __builtin_amdgcn_s_barrier()
#define PG8_SCHED __builtin_amdgcn_sched_barrier(0)
    Unit cur, nxt; int ui = 0;
    if (!S.next(0, cur)) return;
    f32x4 acc[2][2][4][2];
#pragma unroll
    for (int a = 0; a < 2; ++a)
#pragma unroll
        for (int b = 0; b < 2; ++b)
#pragma unroll
            for (int m = 0; m < 4; ++m)
#pragma unroll
                for (int n = 0; n < 2; ++n) acc[a][b][m][n] = (f32x4){0.f, 0.f, 0.f, 0.f};
    bf16x8 At[4][2], B0[2][2], B1[2][2];
    unsigned cO[2][2], nO[2][2];
    S.a_off(cur, Rr, Cc, K, cO);
    const char* cA = S.a_base(g, cur); const char* cB = (const char*)g.Bt + (size_t)cur.pn * tstep;
    PG8_STAGE(PG8_SB(0, 0), cB, voffB); PG8_STAGE(PG8_SB(0, 1), cB + hstep, voffB); PG8_STAGE(PG8_SA(0, 0), cA, cO[0]); PG8_STAGE(PG8_SA(0, 1), cA, cO[1]);
    if (wr == 1) PG8_BAR;
    PG8_WAIT_V(2); PG8_BAR;
    PG8_STAGE(PG8_SB(1, 0), cB + kstep, voffB); PG8_STAGE(PG8_SA(1, 0), cA + kstep, cO[0]); PG8_STAGE(PG8_SB(1, 1), cB + hstep + kstep, voffB);
    PG8_WAIT_V(6); PG8_BAR;
    for (;;) {
        const bool has_next = S.next(ui + 1, nxt);
        const char* nA = cA; const char* nB = cB;
#pragma unroll
        for (int h = 0; h < 2; ++h)
#pragma unroll
            for (int i = 0; i < 2; ++i) nO[h][i] = cO[h][i];
        if (has_next) { S.a_off(nxt, Rr, Cc, K, nO); nA = S.a_base(g, nxt); nB = (const char*)g.Bt + (size_t)nxt.pn * tstep; }
        for (int t = 0; t < nt; t += 2) {
            const bool last = (t == nt - 2);
            const char* a1 = cA + (size_t)(t + 1) * kstep;
            const char* a2 = last ? nA : cA + (size_t)(t + 2) * kstep; const char* b2 = last ? nB : cB + (size_t)(t + 2) * kstep;
            const char* a3 = a2 + kstep; const char* b3 = b2 + kstep;
            unsigned o2[2][2];
#pragma unroll
            for (int h = 0; h < 2; ++h)
#pragma unroll
                for (int i = 0; i < 2; ++i) o2[h][i] = last ? nO[h][i] : cO[h][i];
            PG8_LDB(B0, 0, 0); PG8_LDB(B1, 0, 1); PG8_SCHED; PG8_LDA(At, 0, 0); PG8_STAGE(PG8_SA(1, 1), a1, cO[1]);
            PG8_WAIT_V(8); PG8_WAIT_L(0); PG8_BAR; PG8_MMA(0, 0, At, B0); PG8_MMA(0, 1, At, B1); PG8_BAR; PG8_SCHED;
            PG8_LDA(At, 0, 1); PG8_STAGE(PG8_SB(0, 0), b2, voffB); PG8_STAGE(PG8_SB(0, 1), b2 + hstep, voffB); PG8_STAGE(PG8_SA(0, 0), a2, o2[0]);
            PG8_WAIT_V(8); PG8_WAIT_L(0); PG8_BAR; PG8_MMA(1, 0, At, B0); PG8_MMA(1, 1, At, B1); PG8_BAR; PG8_SCHED;
            PG8_LDB(B0, 1, 0); PG8_LDB(B1, 1, 1); PG8_SCHED; PG8_LDA(At, 1, 0); PG8_STAGE(PG8_SA(0, 1), a2, o2[1]);
            PG8_WAIT_V(8); PG8_WAIT_L(0); PG8_BAR; PG8_MMA(0, 0, At, B0); PG8_MMA(0, 1, At, B1); PG8_BAR; PG8_SCHED;
            PG8_LDA(At, 1, 1); PG8_STAGE(PG8_SB(1, 0), b3, voffB); PG8_STAGE(PG8_SB(1, 1), b3 + hstep, voffB); PG8_STAGE(PG8_SA(1, 0), a3, o2[0]);
            PG8_WAIT_V(8); PG8_WAIT_L(0); PG8_BAR; PG8_MMA(1, 0, At, B0); PG8_MMA(1, 1, At, B1); PG8_BAR; PG8_SCHED;
        }
        if constexpr (ALIGN_EPI) { if (wr == 0) PG8_BAR; }
        E(acc, cur, wr, wc, fr, fq);
        if (!has_next) break;
#pragma unroll
        for (int a = 0; a < 2; ++a)
#pragma unroll
            for (int b = 0; b < 2; ++b)
#pragma unroll
                for (int m = 0; m < 4; ++m)
#pragma unroll
                    for (int n = 0; n < 2; ++n) acc[a][b][m][n] = (f32x4){0.f, 0.f, 0.f, 0.f};
        cur = nxt; cA = nA; cB = nB; ++ui;
#pragma unroll
        for (int h = 0; h < 2; ++h)
#pragma unroll
            for (int i = 0; i < 2; ++i) cO[h][i] = nO[h][i];
        if constexpr (ALIGN_EPI) { if (wr == 1) PG8_BAR; }
    }
    PG8_WAIT_V(0);
    if constexpr (!ALIGN_EPI) { if (wr == 0) PG8_BAR; }
    PG8_BAR;
#undef PG8_SA
#undef PG8_SB
#undef PG8_STAGE
#undef PG8_LDA
#undef PG8_LDB
#undef PG8_MMA
#undef PG8_WAIT_V
#undef PG8_WAIT_L
#undef PG8_BAR
#undef PG8_SCHED
}
}

#define XB_TMO      128
#define XB_XCNT(j)  (256  + 64 * (j))
#define XB_XSUB(j)  (1280 + 64 * (j))
#define XB_XGEN(j)  (2304 + 64 * (j))
#define XB_TOP      3328
#define XB_TOPGEN   3392
#define XCD_BAR_WORDS 3456
#define XB_SPIN_CAP (1u << 18)
__device__ __forceinline__ unsigned xb_ld(unsigned* p)              { return __hip_atomic_load(p, __ATOMIC_RELAXED, __HIP_MEMORY_SCOPE_AGENT); }
__device__ __forceinline__ unsigned xb_add(unsigned* p, unsigned v) { return __hip_atomic_fetch_add(p, v, __ATOMIC_RELAXED, __HIP_MEMORY_SCOPE_AGENT); }
__device__ __forceinline__ unsigned xb_xcc_id() { return (unsigned)__builtin_amdgcn_s_getreg((3 << 11) | 20) & 0xFu; }
#define XB_SPIN(cond, bar) do { unsigned _sp = 0; while (cond) { __builtin_amdgcn_s_sleep(1); \
    if ((++_sp & 255u) == 0u) { if (xb_ld(&(bar)[XB_TMO])) break; if (_sp > XB_SPIN_CAP) { atomicAdd(&(bar)[XB_TMO], 1u); break; } } } } while (0)
struct XcdBarrier { unsigned* bar; unsigned x; volatile LAS unsigned* st; };
__device__ __forceinline__ XcdBarrier xcd_barrier_post(unsigned* bar, volatile LAS unsigned* st) {
    XcdBarrier b; b.bar = bar; b.x = xb_xcc_id(); b.st = st;
    if (threadIdx.x == 0) (void)xb_add(&bar[XB_XCNT(b.x)], 1u);
    return b;
}
__device__ __forceinline__ void xcd_barrier_complete(unsigned* bar, unsigned x, unsigned& nloc, unsigned& nx) {
    const unsigned G = gridDim.x * gridDim.y * gridDim.z;
    unsigned sum, cnt, mine, sp = 0u;
    for (;;) {
        sum = 0u; cnt = 0u; mine = 0u;
#pragma unroll
        for (unsigned j = 0; j < 16; ++j) { const unsigned c = xb_ld(&bar[XB_XCNT(j)]); sum += c; cnt += (c > 0u) ? 1u : 0u; mine = (j == x) ? c : mine; }
        if (sum == G) break;
        __builtin_amdgcn_s_sleep(1);
        if ((++sp & 255u) == 0u) { if (xb_ld(&bar[XB_TMO])) break; if (sp > XB_SPIN_CAP) { atomicAdd(&bar[XB_TMO], 1u); break; } }
    }
    nloc = mine > 0u ? mine : 1u; nx = cnt > 0u ? cnt : 1u;
}
__device__ __forceinline__ void xcd_barrier(const XcdBarrier& b) {
    asm volatile("s_waitcnt vmcnt(0)" ::: "memory");
    __syncthreads();
    if (threadIdx.x == 0) {
        unsigned* bar = b.bar;
        __builtin_amdgcn_s_waitcnt(0);
        unsigned nloc = b.st[0], nx = b.st[1];
        if (nloc == 0u) { xcd_barrier_complete(bar, b.x, nloc, nx); b.st[0] = nloc; b.st[1] = nx; }
        const unsigned old = xb_add(&bar[XB_XSUB(b.x)], 1u);
        const unsigned gen = old / nloc;
        if (old + 1u == (gen + 1u) * nloc) {
            __builtin_amdgcn_fence(__ATOMIC_RELEASE, "agent");
            asm volatile("s_waitcnt vmcnt(0)" ::: "memory");
            const unsigned og = xb_add(&bar[XB_TOP], 1u);
            const unsigned tg = og / nx;
            if (og + 1u == (tg + 1u) * nx) xb_add(&bar[XB_TOPGEN], 1u);
            else XB_SPIN(xb_ld(&bar[XB_TOPGEN]) == tg, bar);
            __builtin_amdgcn_fence(__ATOMIC_ACQUIRE, "agent");
            xb_add(&bar[XB_XGEN(b.x)], 1u);
            asm volatile("s_waitcnt vmcnt(0)" ::: "memory");
        } else {
            XB_SPIN(xb_ld(&bar[XB_XGEN(b.x)]) == gen, bar);
            __builtin_amdgcn_fence(__ATOMIC_ACQUIRE, "agent");
            asm volatile("s_waitcnt vmcnt(0)" ::: "memory");
        }
    }
    __syncthreads();
}

struct Frame {
    LAS unsigned char* lds;
    volatile LAS unsigned* MISC;
    gu32* ctl;
    int tid, lane, wave, vcu, G;
};
struct Args {
    const float* in[26]; float* out; unsigned char* ws; int ph_lo, ph_hi;
};

__device__ __forceinline__ void p0_transpose_item(const float* W, int N, int k0, int n0, bf16* WT, size_t drow0, int Kd, LAS float* scr, int lane) {
    const int lq = lane & 15, lk = lane >> 4;
#pragma unroll 8
    for (int i = 0; i < 16; ++i) { const int kk = 4 * i + lk; const f32x4 v = *(const f32x4*)(W + (size_t)(k0 + kk) * N + n0 + 4 * lq);
        LAS float* s = scr + kk * 65 + 4 * lq; s[0] = v.x; s[1] = v.y; s[2] = v.z; s[3] = v.w; }
    LDS_WAIT(); asm volatile("" ::: "memory");
    const int c = lane & 7;
#pragma unroll
    for (int j = 0; j < 8; ++j) { const int n = (lane >> 3) + 8 * j; const LAS float* s = scr + (8 * c) * 65 + n;
        v4u o; o.x = cvtpk(s[0 * 65], s[1 * 65]); o.y = cvtpk(s[2 * 65], s[3 * 65]); o.z = cvtpk(s[4 * 65], s[5 * 65]); o.w = cvtpk(s[6 * 65], s[7 * 65]);
        *(v4u*)(WT + (drow0 + n) * (size_t)Kd + k0 + 8 * c) = o; }
    LDS_WAIT(); asm volatile("" ::: "memory");
}
__device__ __forceinline__ void p0_mod_unit(Frame& F, const float* c, const float* ada_w, const float* ada_b, float* mod, int unit) {
    const int n0 = unit * 64, lane = F.lane, w = F.wave, k0 = w * 256;
    LAS float* sc = (LAS float*)(F.lds + w * 16384);
    for (int b = 0; b < NB; ++b)
#pragma unroll
        for (int j = 0; j < 4; ++j) { const float v = c[(size_t)b * D + k0 + 64 * j + lane]; sc[(64 * j + lane) * 16 + b] = v * sigmoidf_(v); }
    LDS_WAIT(); asm volatile("" ::: "memory");
    float acc[NB][4];
#pragma unroll
    for (int b = 0; b < NB; ++b)
#pragma unroll
        for (int j = 0; j < 4; ++j) acc[b][j] = 0.f;
    const int lq = lane & 15, lk = lane >> 4;
#pragma unroll 4
    for (int i = 0; i < 64; ++i) { const int kk = 4 * i + lk; const f32x4 wv = *(const f32x4*)(ada_w + (size_t)(k0 + kk) * (6 * D) + n0 + 4 * lq);
        const LAS f32x4* sp = (const LAS f32x4*)(sc + kk * 16);
#pragma unroll
        for (int q = 0; q < 4; ++q) { const f32x4 s4 = sp[q];
#pragma unroll
            for (int bb = 0; bb < 4; ++bb)
#pragma unroll
                for (int j = 0; j < 4; ++j) acc[q * 4 + bb][j] += s4[bb] * wv[j]; } }
    LDS_WAIT(); asm volatile("" ::: "memory");
    LAS f32x4* rp = (LAS f32x4*)(F.lds + w * 16384) + lane * 16;
#pragma unroll
    for (int b = 0; b < NB; ++b) rp[b] = (f32x4){acc[b][0], acc[b][1], acc[b][2], acc[b][3]};
    LDS_WAIT(); __syncthreads();
    for (int o = F.tid; o < NB * 64; o += NWAVES * 64) { const int b = o >> 6, n = o & 63, q = n >> 2, j = n & 3; float s = 0.f;
#pragma unroll
        for (int ww = 0; ww < 8; ++ww)
#pragma unroll
            for (int gq = 0; gq < 4; ++gq) s += ((const LAS float*)(F.lds + ww * 16384))[(gq * 16 + q) * 64 + b * 4 + j];
        mod[(size_t)b * (6 * D) + n0 + n] = s + ada_b[n0 + n]; }
    LDS_WAIT(); __syncthreads();
}

__device__ __forceinline__ void modnorm_rows(Frame& F, const float* xin, bf16* xn, const float* gain, const float* shift, const float* scale, int r0, int nrows) {
    f32x4 mu[8], ad[8];
#pragma unroll
    for (int j = 0; j < 8; ++j) { const f32x4 g = ((const f32x4*)gain)[F.lane + 64 * j], sc = ((const f32x4*)scale)[F.lane + 64 * j]; mu[j] = g * (1.0f + sc); ad[j] = ((const f32x4*)shift)[F.lane + 64 * j]; }
    for (int r = r0; r < r0 + nrows; ++r) {
        const f32x4* xr = (const f32x4*)(xin + (size_t)r * D) + F.lane;
        f32x4 v[8]; float s = 0.f;
#pragma unroll
        for (int j = 0; j < 8; ++j) { v[j] = xr[64 * j]; s += (v[j].x * v[j].x + v[j].y * v[j].y) + (v[j].z * v[j].z + v[j].w * v[j].w); }
        const float rstd = 1.0f / sqrtf(wave_sum(s) * (1.0f / D) + EPS);
        v2u* o8 = (v2u*)(xn + (size_t)r * D) + F.lane;
#pragma unroll
        for (int j = 0; j < 8; ++j) { const f32x4 h = v[j] * rstd * mu[j] + ad[j]; v2u w; w.x = cvtpk(h.x, h.y); w.y = cvtpk(h.z, h.w); o8[64 * j] = w; }
    }
}

__device__ __forceinline__ float gelu_tanh(float x) {
    const float t = 1.5957691216f * (x + 0.044715f * x * x * x);
    return x * sigmoidf_(t);
}
__device__ __forceinline__ void mixer_a_unit(Frame& F, const bf16* proj, bf16* Y, const float* conv3_w, const float* gconv, int ua) {
    const int ch0 = (F.wave & 1) * 512 + F.lane * 8, t0 = ua * 256 + (F.wave >> 1) * 64;
    float w0[8], w1[8], w2[8], gg[8];
#pragma unroll
    for (int j = 0; j < 8; ++j) { w0[j] = conv3_w[ch0 + j]; w1[j] = conv3_w[DC + ch0 + j]; w2[j] = conv3_w[2 * DC + ch0 + j]; gg[j] = gconv[ch0 + j]; }
    float u1[8], u2[8];
    const bool hist = (t0 % SEQ) != 0;
    {
        v4u c1 = {0, 0, 0, 0}, x1 = {0, 0, 0, 0}, c2 = {0, 0, 0, 0}, x2 = {0, 0, 0, 0};
        if (hist) { const bf16* p1 = proj + (size_t)(t0 - 1) * DIN + ch0; const bf16* p2 = proj + (size_t)(t0 - 2) * DIN + ch0;
            c1 = *(const v4u*)(p1 + DC); x1 = *(const v4u*)(p1 + 2 * DC); c2 = *(const v4u*)(p2 + DC); x2 = *(const v4u*)(p2 + 2 * DC); }
#pragma unroll
        for (int q = 0; q < 4; ++q) { u1[2 * q] = bf_lo(c1[q]) * bf_lo(x1[q]); u1[2 * q + 1] = bf_hi(c1[q]) * bf_hi(x1[q]); u2[2 * q] = bf_lo(c2[q]) * bf_lo(x2[q]); u2[2 * q + 1] = bf_hi(c2[q]) * bf_hi(x2[q]); }
    }
#pragma unroll 4
    for (int t = t0; t < t0 + 64; ++t) {
        const bf16* p = proj + (size_t)t * DIN + ch0;
        const v4u bv = *(const v4u*)p, cv = *(const v4u*)(p + DC), xv = *(const v4u*)(p + 2 * DC);
        float y[8]; float ss = 0.f;
#pragma unroll
        for (int q = 0; q < 4; ++q) {
            const float ua0 = bf_lo(cv[q]) * bf_lo(xv[q]), ub0 = bf_hi(cv[q]) * bf_hi(xv[q]);
            const float va = w0[2 * q] * u2[2 * q] + w1[2 * q] * u1[2 * q] + w2[2 * q] * ua0;
            const float vb = w0[2 * q + 1] * u2[2 * q + 1] + w1[2 * q + 1] * u1[2 * q + 1] + w2[2 * q + 1] * ub0;
            u2[2 * q] = u1[2 * q]; u1[2 * q] = ua0; u2[2 * q + 1] = u1[2 * q + 1]; u1[2 * q + 1] = ub0;
            y[2 * q] = bf_lo(bv[q]) * va; y[2 * q + 1] = bf_hi(bv[q]) * vb;
            ss += y[2 * q] * y[2 * q] + y[2 * q + 1] * y[2 * q + 1];
        }
        ss += __shfl_xor(ss, 1); ss += __shfl_xor(ss, 2); ss += __shfl_xor(ss, 4);
        const float rstd = fast_rsq(ss * (1.0f / CONV_HD) + EPS);
        v4u o;
#pragma unroll
        for (int q = 0; q < 4; ++q) o[q] = cvtpk(y[2 * q] * rstd * gg[2 * q], y[2 * q + 1] * rstd * gg[2 * q + 1]);
        *(v4u*)(Y + (size_t)t * D + ch0) = o;
    }
}
constexpr int MB_TB = 128, MB_PITCH = 272;
constexpr int MB_XI = 0, MB_ST = MB_TB * MB_PITCH, MB_SS = 2 * MB_TB * MB_PITCH, MB_C4 = MB_SS + 8 * MB_TB * 4, MB_END = MB_C4 + 5 * 128 * 4;
static_assert(MB_END <= LDSCTL_OFF, "mixer B LDS");
__device__ __forceinline__ void mixer_b_unit(Frame& F, const bf16* proj, bf16* Y, const float* conv4_w, const float* conv4_b, const float* lru_w_a, const float* lru_b_a,
                                             const float* lru_w_x, const float* lru_b_x, const float* lam, const float* glru, int unit) {
    const int b = unit >> 3, hd = unit & 7, lane = F.lane, w = F.wave, c = lane & 15, kg = lane >> 4;
    LAS float* C4 = (LAS float*)(F.lds + MB_C4);
    __syncthreads();
    for (int idx = F.tid; idx < 5 * 128; idx += NWAVES * 64) { const int tap = idx >> 7, ch = idx & 127; C4[idx] = tap < 4 ? conv4_w[tap * DL + hd * 128 + ch] : conv4_b[hd * 128 + ch]; }
    bf16x8 fa[4], fx[4];
#pragma unroll
    for (int ks = 0; ks < 4; ++ks) { float ta[8], tx[8];
#pragma unroll
        for (int j = 0; j < 8; ++j) { const size_t o = (size_t)hd * 16384 + (size_t)(32 * ks + 8 * kg + j) * 128 + 16 * w + c; ta[j] = lru_w_a[o]; tx[j] = lru_w_x[o]; }
        v4u pa, px; pa.x = cvtpk(ta[0], ta[1]); pa.y = cvtpk(ta[2], ta[3]); pa.z = cvtpk(ta[4], ta[5]); pa.w = cvtpk(ta[6], ta[7]);
        px.x = cvtpk(tx[0], tx[1]); px.y = cvtpk(tx[2], tx[3]); px.z = cvtpk(tx[4], tx[5]); px.w = cvtpk(tx[6], tx[7]);
        fa[ks] = __builtin_bit_cast(bf16x8, pa); fx[ks] = __builtin_bit_cast(bf16x8, px); }
    bf16x8 idn;
#pragma unroll
    for (int j = 0; j < 8; ++j) idn[j] = (8 * kg + j == 16 * (w & 1) + c) ? (short)0x3f80 : (short)0;
    const int ch = hd * 128 + 16 * w + c;
    const float ba = lru_b_a[ch], bx = lru_b_x[ch], nsp = -8.0f * log1pf(expf(-lam[ch]));
    const int pc = F.tid & 15, tg = F.tid >> 4;
    float gl8[8];
#pragma unroll
    for (int j = 0; j < 8; ++j) gl8[j] = glru[hd * 128 + pc * 8 + j];
    LAS unsigned char* xi_w = F.lds + MB_XI + (4 * tg) * MB_PITCH + pc * 16;
    LAS unsigned char* xi_r = F.lds + MB_XI + c * MB_PITCH + kg * 16;
    LAS unsigned char* st_w = F.lds + MB_ST + (4 * kg) * MB_PITCH + (16 * w + c) * 2;
    LAS float* ss_w = (LAS float*)(F.lds + MB_SS) + w * MB_TB + 4 * kg;
    LAS unsigned char* c4l = F.lds + MB_C4 + pc * 32;
    asm volatile("" : "+v"(xi_w), "+v"(xi_r), "+v"(st_w), "+v"(ss_w), "+v"(c4l));
    const bf16* xb = proj + (size_t)b * SEQ * DIN + 4 * 1024 + hd * 128 + pc * 8;
    const bf16* gb = proj + (size_t)b * SEQ * DIN + 3 * 1024 + hd * 128 + 32 * (w >> 1) + 8 * kg;
    bf16* yo = Y + (size_t)b * SEQ * D + DC + hd * 128 + pc * 8;
    float hc = 0.f;
    LDS_WAIT(); __syncthreads();
#pragma unroll 1
    for (int tb = 0; tb < SEQ / MB_TB; ++tb) {
        const int t0 = tb * MB_TB;
        {
            float wt[4][8], bs[8];
#pragma unroll
            for (int tap = 0; tap < 4; ++tap) { const LAS f32x4* wp = (const LAS f32x4*)(c4l + tap * 512); const f32x4 wa = wp[0], wb = wp[1];
                wt[tap][0] = wa.x; wt[tap][1] = wa.y; wt[tap][2] = wa.z; wt[tap][3] = wa.w; wt[tap][4] = wb.x; wt[tap][5] = wb.y; wt[tap][6] = wb.z; wt[tap][7] = wb.w; }
            { const LAS f32x4* wp = (const LAS f32x4*)(c4l + 4 * 512); const f32x4 wa = wp[0], wb = wp[1]; bs[0] = wa.x; bs[1] = wa.y; bs[2] = wa.z; bs[3] = wa.w; bs[4] = wb.x; bs[5] = wb.y; bs[6] = wb.z; bs[7] = wb.w; }
            v4u rows[7];
#pragma unroll
            for (int i = 0; i < 7; ++i) { const int tt = t0 + 4 * tg - 3 + i; rows[i] = (v4u){0, 0, 0, 0}; if (tt >= 0) rows[i] = *(const v4u*)(xb + (size_t)tt * DIN); }
#pragma unroll
            for (int i = 0; i < 4; ++i) { float xc[8];
#pragma unroll
                for (int j = 0; j < 8; ++j) xc[j] = bs[j];
#pragma unroll
                for (int tap = 0; tap < 4; ++tap) { const v4u v = rows[i + tap];
                    xc[0] += wt[tap][0] * bf_lo(v.x); xc[1] += wt[tap][1] * bf_hi(v.x); xc[2] += wt[tap][2] * bf_lo(v.y); xc[3] += wt[tap][3] * bf_hi(v.y);
                    xc[4] += wt[tap][4] * bf_lo(v.z); xc[5] += wt[tap][5] * bf_hi(v.z); xc[6] += wt[tap][6] * bf_lo(v.w); xc[7] += wt[tap][7] * bf_hi(v.w); }
                v4u p; p.x = cvtpk(xc[0], xc[1]); p.y = cvtpk(xc[2], xc[3]); p.z = cvtpk(xc[4], xc[5]); p.w = cvtpk(xc[6], xc[7]);
                *(LAS v4u*)(xi_w + i * MB_PITCH) = p; }
        }
        LDS_WAIT(); __syncthreads();
#pragma unroll 1
        for (int s = 0; s < MB_TB / 16; ++s) {
            const bf16x8 gfr = *(const bf16x8*)(gb + (size_t)(t0 + 16 * s + c) * DIN);
            f32x4 ar = {0.f, 0.f, 0.f, 0.f}, ai = ar, ax = ar, ag = ar;
            const LAS unsigned char* xr = xi_r + s * (16 * MB_PITCH);
#pragma unroll
            for (int ks = 0; ks < 4; ++ks) { const bf16x8 af = *(const LAS bf16x8*)(xr + ks * 64);
                ar = __builtin_amdgcn_mfma_f32_16x16x32_bf16(af, fa[ks], ar, 0, 0, 0);
                ai = __builtin_amdgcn_mfma_f32_16x16x32_bf16(af, fx[ks], ai, 0, 0, 0); }
            { const bf16x8 af = *(const LAS bf16x8*)(xr + (w >> 1) * 64); ax = __builtin_amdgcn_mfma_f32_16x16x32_bf16(af, idn, ax, 0, 0, 0); }
            ag = __builtin_amdgcn_mfma_f32_16x16x32_bf16(gfr, idn, ag, 0, 0, 0);
            float Hl[4], Pl[4]; float h = 0.f, P = 1.f;
#pragma unroll
            for (int v = 0; v < 4; ++v) {
                const float r = sigmoidf_(ar[v] + ba), ig = sigmoidf_(ai[v] + bx);
                const float la = nsp * r, a = fast_exp(la), z = 2.0f * la;
                const float em1 = z * (1.0f + z * (0.5f + z * (0.16666667f + z * (0.041666668f + z * 0.0083333333f))));
                const float om = (z > -0.35f) ? -em1 : 1.0f - fast_exp(z);
                const float u = fast_sqrt(om) * ig * ax[v];
                h = a * h + u; P *= a; Hl[v] = h; Pl[v] = P; }
            float X = hc, Xn = hc;
#pragma unroll
            for (int g = 0; g < 4; ++g) { const float pg = __shfl(P, c + 16 * g), hg = __shfl(h, c + 16 * g); if (g == kg) X = Xn; Xn = pg * Xn + hg; }
            hc = Xn;
            float yb[4]; f32x4 ss;
#pragma unroll
            for (int v = 0; v < 4; ++v) { const float hv = Pl[v] * X + Hl[v]; yb[v] = hv * gelu_tanh(ag[v]); ss[v] = yb[v] * yb[v]; }
#pragma unroll
            for (int o = 1; o < 16; o <<= 1) { ss[0] += __shfl_xor(ss[0], o); ss[1] += __shfl_xor(ss[1], o); ss[2] += __shfl_xor(ss[2], o); ss[3] += __shfl_xor(ss[3], o); }
            if (c == 0) *(LAS f32x4*)(ss_w + 16 * s) = ss;
#pragma unroll
            for (int v = 0; v < 4; ++v) *(LAS bf16*)(st_w + (16 * s + v) * MB_PITCH) = (bf16)(cvtpk(yb[v], 0.f) & 0xffffu);
        }
        LDS_WAIT(); __syncthreads();
#pragma unroll
        for (int i = 0; i < 4; ++i) { const int tk = 4 * tg + i; float sq = 0.f;
#pragma unroll
            for (int ww = 0; ww < 8; ++ww) sq += ((const LAS float*)(F.lds + MB_SS))[ww * MB_TB + tk];
            const float rstd = fast_rsq(sq * (1.0f / LRU_HD) + EPS);
            const v4u p = *(const LAS v4u*)(xi_w + (MB_ST - MB_XI) + i * MB_PITCH);
            v4u o; o.x = cvtpk(bf_lo(p.x) * rstd * gl8[0], bf_hi(p.x) * rstd * gl8[1]); o.y = cvtpk(bf_lo(p.y) * rstd * gl8[2], bf_hi(p.y) * rstd * gl8[3]);
            o.z = cvtpk(bf_lo(p.z) * rstd * gl8[4], bf_hi(p.z) * rstd * gl8[5]); o.w = cvtpk(bf_lo(p.w) * rstd * gl8[6], bf_hi(p.w) * rstd * gl8[7]);
            *(v4u*)(yo + (size_t)(t0 + tk) * D) = o; }
    }
    __syncthreads();
}

constexpr int P5_ROWB = 4112;
constexpr int P5_HI = 0, P5_LO = 16 * P5_ROWB, P5_END = 2 * 16 * P5_ROWB;
static_assert(P5_END <= LDSCTL_OFF && 8 * 16 * NRC * 4 <= P5_END, "P5 LDS");
__device__ __forceinline__ void p5_pass(Frame& F, const float* x1, bf16* xn, const f32x4 (&mu)[8], const f32x4 (&ad)[8], const bf16* wr_hi, const bf16* wr_lo,
                                        const float* rbg, const float* rbe, int row0, int* rout, int* ltok, float* lwt) {
    const int lane = F.lane, w = F.wave;
#pragma unroll 1
    for (int rr = 0; rr < 2; ++rr) { const int lr = 2 * w + rr, r = row0 + lr;
        const f32x4* xr = (const f32x4*)(x1 + (size_t)r * D) + lane;
        f32x4 v[8]; float s = 0.f;
#pragma unroll
        for (int j = 0; j < 8; ++j) { v[j] = xr[64 * j]; s += (v[j].x * v[j].x + v[j].y * v[j].y) + (v[j].z * v[j].z + v[j].w * v[j].w); }
        const float rstd = 1.0f / sqrtf(wave_sum(s) * (1.0f / D) + EPS);
        v2u* o8 = (v2u*)(xn + (size_t)r * D) + lane;
#pragma unroll
        for (int j = 0; j < 8; ++j) { const f32x4 h = v[j] * rstd * mu[j] + ad[j]; v2u hi; hi.x = cvtpk(h.x, h.y); hi.y = cvtpk(h.z, h.w); o8[64 * j] = hi;
            v2u lo; lo.x = cvtpk(h.x - bf_lo(hi.x), h.y - bf_hi(hi.x)); lo.y = cvtpk(h.z - bf_lo(hi.y), h.w - bf_hi(hi.y));
            *(LAS v2u*)(F.lds + P5_HI + lr * P5_ROWB + (lane + 64 * j) * 8) = hi; *(LAS v2u*)(F.lds + P5_LO + lr * P5_ROWB + (lane + 64 * j) * 8) = lo; }
    }
    LDS_WAIT(); __syncthreads();
    const int fr = lane & 15, fq = lane >> 4;
    f32x4 acc[5];
#pragma unroll
    for (int t = 0; t < 5; ++t) acc[t] = (f32x4){0.f, 0.f, 0.f, 0.f};
#pragma unroll 1
    for (int ks = 0; ks < 8; ++ks) { const int k = w * 256 + ks * 32 + 8 * fq;
        const bf16x8 ah = *(const LAS bf16x8*)(F.lds + P5_HI + fr * P5_ROWB + k * 2), al = *(const LAS bf16x8*)(F.lds + P5_LO + fr * P5_ROWB + k * 2);
#pragma unroll
        for (int t = 0; t < 5; ++t) { const bf16x8 bh = *(const bf16x8*)(wr_hi + (size_t)(t * 16 + fr) * D + k), bl = *(const bf16x8*)(wr_lo + (size_t)(t * 16 + fr) * D + k);
            acc[t] = __builtin_amdgcn_mfma_f32_16x16x32_bf16(ah, bh, acc[t], 0, 0, 0);
            acc[t] = __builtin_amdgcn_mfma_f32_16x16x32_bf16(ah, bl, acc[t], 0, 0, 0);
            acc[t] = __builtin_amdgcn_mfma_f32_16x16x32_bf16(al, bh, acc[t], 0, 0, 0); } }
    LDS_WAIT(); __syncthreads();
    LAS float* PS = (LAS float*)F.lds;
#pragma unroll
    for (int t = 0; t < 5; ++t)
#pragma unroll
        for (int j = 0; j < 4; ++j) PS[(w * 16 + fq * 4 + j) * NRC + t * 16 + fr] = acc[t][j];
    LDS_WAIT(); __syncthreads();
    if (F.tid < 16) { const int lr = F.tid, r = row0 + lr;
        float gl_[8]; float mx = -3.0e38f; int gi = 0;
#pragma unroll
        for (int c = 0; c < 8; ++c) { float s = 0.f;
#pragma unroll
            for (int ww = 0; ww < 8; ++ww) s += PS[(ww * 16 + lr) * NRC + c];
            gl_[c] = s + rbg[c]; if (gl_[c] > mx) { mx = gl_[c]; gi = c; } }
        float den = 0.f;
#pragma unroll
        for (int c = 0; c < 8; ++c) den += expf(gl_[c] - mx);
        const float pg = 1.0f / den;
        float v0 = -3.0e38f, v1 = -3.0e38f; int i0 = 0, i1 = 0;
#pragma unroll
        for (int e = 0; e < 8; ++e) { float s = 0.f;
#pragma unroll
            for (int ww = 0; ww < 8; ++ww) s += PS[(ww * 16 + lr) * NRC + 8 + gi * 8 + e];
            const float le = s + rbe[gi * 8 + e];
            if (le > v0) { v1 = v0; i1 = i0; v0 = le; i0 = e; } else if (le > v1) { v1 = le; i1 = e; } }
        const float ex = expf(v1 - v0), w0 = pg / (1.0f + ex), w1 = pg * ex / (1.0f + ex);
        const int e0 = gi * 8 + i0, e1 = gi * 8 + i1;
        const unsigned p0 = __hip_atomic_fetch_add((unsigned*)(F.ctl + CW_CNT + 64 * e0), 1u, RLX_AGENT);
        const unsigned p1 = __hip_atomic_fetch_add((unsigned*)(F.ctl + CW_CNT + 64 * e1), 1u, RLX_AGENT);
        ltok[(size_t)e0 * LISTCAP + p0] = r; lwt[(size_t)e0 * LISTCAP + p0] = w0;
        ltok[(size_t)e1 * LISTCAP + p1] = r; lwt[(size_t)e1 * LISTCAP + p1] = w1;
        *(int4*)(rout + (size_t)r * 4) = make_int4(e0, e1, (int)p0, (int)p1);
    }
    LDS_WAIT(); __syncthreads();
}

__device__ __forceinline__ void build_tables(Frame& F) {
    LAS int* tstart = (LAS int*)(F.lds + TAB_OFF); LAS int* texp = tstart + 80;
    __syncthreads();
    if (F.tid < 64) {
        const unsigned c = __hip_atomic_load((unsigned*)(F.ctl + CW_CNT + 64 * F.tid), RLX_AGENT);
        int tl = (int)((c + 255u) >> 8), incl = tl;
#pragma unroll
        for (int o = 1; o < 64; o <<= 1) { const int t = __shfl_up(incl, o); if (F.lane >= o) incl += t; }
        tstart[F.tid + 1] = incl; if (F.tid == 0) tstart[0] = 0;
    }
    LDS_WAIT(); __syncthreads();
    for (int mt = F.tid; mt < MT_MAX; mt += NWAVES * 64) { int e = 0;
        for (int j = 1; j < NE; ++j) e += (tstart[j] <= mt) ? 1 : 0;
        texp[mt] = e; }
    LDS_WAIT(); __syncthreads();
}

constexpr int N_PHASES = 9;
__global__ void __launch_bounds__(NWAVES * 64, 2) hybrid_fwd(Args args) {
    extern __shared__ __attribute__((aligned(16))) unsigned char lds[];
    Frame F;
    F.lds = (LAS unsigned char*)lds;
    F.MISC = (volatile LAS unsigned*)(F.lds + MISC_OFF);
    F.tid = threadIdx.x; F.lane = F.tid & 63; F.wave = __builtin_amdgcn_readfirstlane(F.tid >> 6);
    F.G = gridDim.x; { const int bx = blockIdx.x; F.vcu = (F.G % 8 == 0) ? (bx % 8) * (F.G / 8) + bx / 8 : bx; }
    unsigned char* ws = args.ws;
    F.ctl = (gu32*)(ws + WS_CTL);
    const float* x = args.in[0]; const float* cvec = args.in[1]; const float* ada_w = args.in[2]; const float* ada_b = args.in[3]; const float* norm1_g = args.in[4];
    const float* w_in = args.in[5]; const float* conv3_w = args.in[6]; const float* conv4_w = args.in[7]; const float* conv4_b = args.in[8];
    const float* lru_w_a = args.in[9]; const float* lru_b_a = args.in[10]; const float* lru_w_x = args.in[11]; const float* lru_b_x = args.in[12]; const float* lru_lambda = args.in[13];
    const float* hn_conv_g = args.in[14]; const float* hn_lru_g = args.in[15]; const float* w_out = args.in[16]; const float* norm2_g = args.in[17];
    const float* rwg = args.in[18]; const float* rbg = args.in[19]; const float* rwe = args.in[20]; const float* rbe = args.in[21];
    const float* w_e_gate = args.in[22]; const float* w_e_up = args.in[23]; const float* w_e_down = args.in[24]; const float* final_g = args.in[25];
    float* out = args.out;
    float* mod = (float*)(ws + WS_MOD); int* rout = (int*)(ws + WS_ROUT);
    bf16* wr_hi = (bf16*)(ws + WS_WR); bf16* wr_lo = wr_hi + NRC * D;
    int* ltok = (int*)(ws + WS_LTOK); float* lwt = (float*)(ws + WS_LW);
    bf16* Win_t = (bf16*)(ws + WS_WIN); bf16* Wout_t = (bf16*)(ws + WS_WOUT); bf16* Wgu_t = (bf16*)(ws + WS_WGU); bf16* Wd_t = (bf16*)(ws + WS_WD);
    bf16* XN = (bf16*)(ws + WS_XN); bf16* PROJ = (bf16*)(ws + WS_PROJ); bf16* YE = (bf16*)(ws + WS_PROJ); bf16* Y = (bf16*)(ws + WS_Y); bf16* HB = (bf16*)(ws + WS_Y);

    for (int u = F.tid; u < (LDS_BYTES - LDSCTL_OFF) / 4; u += NWAVES * 64) ((LAS unsigned*)(F.lds + LDSCTL_OFF))[u] = 0u;
    __syncthreads();
    XcdBarrier bar; bar.bar = (unsigned*)(F.ctl + CW_BAR); bar.x = 0; bar.st = nullptr;
    if (MK_N_LAUNCHES == 1) bar = xcd_barrier_post((unsigned*)(F.ctl + CW_BAR), F.MISC + 8);
    const int lo = args.ph_lo, hi = args.ph_hi;
#ifndef PHASE_MASK
#define PHASE_MASK 0x1ff
#endif
#define IN(k) (((PHASE_MASK >> (k)) & 1) && lo <= (k) && (k) < hi)
#define SEAM(k) do { if (IN(k) && IN((k) + 1)) xcd_barrier(bar); } while (0)
    const int gw = F.vcu * NWAVES + F.wave, NGW = F.G * NWAVES;

    if (IN(0)) {
        for (int u = blockIdx.x; u < (6 * D) / 64; u += F.G) p0_mod_unit(F, cvec, ada_w, ada_b, mod, u);
        for (int idx = blockIdx.x * (NWAVES * 64) + F.tid; idx < NRC * D; idx += F.G * NWAVES * 64) { const int n = idx / D, k = idx % D;
            const float v = n < 8 ? rwg[k * 8 + n] : (n < 72 ? rwe[(size_t)((n - 8) >> 3) * D * 8 + k * 8 + ((n - 8) & 7)] : 0.f);
            const unsigned h = cvtpk(v, 0.f) & 0xffffu; wr_hi[idx] = (bf16)h; wr_lo[idx] = (bf16)(cvtpk(v - bf_lo(h), 0.f) & 0xffffu); }
        LAS float* scr = (LAS float*)(F.lds + F.wave * 16640);
        constexpr int I_IN = (D / 64) * (DIN / 64), I_OUT = (D / 64) * (D / 64), I_GU = NE * (D / 64) * (DE / 64), I_DN = NE * (DE / 64) * (D / 64);
        constexpr int NITEMS = I_IN + I_OUT + 2 * I_GU + I_DN;
        for (int it = gw; it < NITEMS; it += NGW) {
            int r = it;
            if (r < I_IN) { const int nb = r % (DIN / 64), kb = r / (DIN / 64); p0_transpose_item(w_in, DIN, kb * 64, nb * 64, Win_t, (size_t)nb * 64, D, scr, F.lane); continue; } r -= I_IN;
            if (r < I_OUT) { const int nb = r % (D / 64), kb = r / (D / 64); p0_transpose_item(w_out, D, kb * 64, nb * 64, Wout_t, (size_t)nb * 64, D, scr, F.lane); continue; } r -= I_OUT;
            if (r < 2 * I_GU) { const int up = r >= I_GU ? 1 : 0; r -= up * I_GU; const int e = r / ((D / 64) * (DE / 64)), rr = r % ((D / 64) * (DE / 64)), nb = rr % (DE / 64), kb = rr / (DE / 64), n0 = nb * 64;
                p0_transpose_item((up ? w_e_up : w_e_gate) + (size_t)e * D * DE, DE, kb * 64, n0, Wgu_t, (size_t)e * 1024 + (n0 >> 7) * 256 + up * 128 + (n0 & 127), D, scr, F.lane); continue; } r -= 2 * I_GU;
            { const int e = r / ((DE / 64) * (D / 64)), rr = r % ((DE / 64) * (D / 64)), nb = rr % (D / 64), kb = rr / (D / 64);
                p0_transpose_item(w_e_down + (size_t)e * DE * D, D, kb * 64, nb * 64, Wd_t, (size_t)e * D + nb * 64, DE, scr, F.lane); }
        }
    }
    SEAM(0);
    if (IN(1)) {
        for (int grp = gw; grp < M / 16; grp += NGW) { const int r0 = grp * 16, b = r0 / SEQ; const float* mb = mod + (size_t)b * (6 * D);
            modnorm_rows(F, x, XN, norm1_g, mb, mb + D, r0, 16); }
    }
    SEAM(1);
    if (IN(2)) {
        pg8::Gemm g{XN, Win_t, D}; pg8::StaticOrder S; S.init(M, DIN, F.G, (int)blockIdx.x);
        pg8::EpiBf16 E{PROJ, DIN};
        pg8::gemm_phase<pg8::EpiBf16, pg8::StaticOrder, true>(F.lds, g, S, E);
    }
    SEAM(2);
    if (IN(3)) {
        for (int u = blockIdx.x; u < 256; u += F.G) {
#ifndef NO_MIXB
            if (u < 128) mixer_b_unit(F, PROJ, Y, conv4_w, conv4_b, lru_w_a, lru_b_a, lru_w_x, lru_b_x, lru_lambda, hn_lru_g, u);
#endif
#ifndef NO_MIXA
            if (u >= 128) mixer_a_unit(F, PROJ, Y, conv3_w, hn_conv_g, u - 128);
#endif
        }
    }
    SEAM(3);
    if (IN(4)) {
        pg8::Gemm g{Y, Wout_t, D}; pg8::StaticOrder S; S.init(M, D, F.G, (int)blockIdx.x);
        pg8::EpiRes E{x, out, mod + 2 * D};
        pg8::gemm_phase<pg8::EpiRes, pg8::StaticOrder, true>(F.lds, g, S, E);
    }
    SEAM(4);
    if (IN(5)) {
        for (int grp = blockIdx.x; grp < M / 128; grp += F.G) { const int b = (grp * 128) / SEQ; const float* mb = mod + (size_t)b * (6 * D);
            f32x4 mu[8], ad[8];
#pragma unroll
            for (int j = 0; j < 8; ++j) { const f32x4 g = ((const f32x4*)norm2_g)[F.lane + 64 * j], sc = ((const f32x4*)(mb + 4 * D))[F.lane + 64 * j]; mu[j] = g * (1.0f + sc); ad[j] = ((const f32x4*)(mb + 3 * D))[F.lane + 64 * j]; }
#pragma unroll 1
            for (int p = 0; p < 8; ++p) p5_pass(F, out, XN, mu, ad, wr_hi, wr_lo, rbg, rbe, grp * 128 + p * 16, rout, ltok, lwt);
        }
    }
    SEAM(5);
    if (IN(6)) {
        build_tables(F);
        pg8::Gemm g{XN, Wgu_t, D};
        pg8::GroupedOrder<4, true> S{(const LAS int*)(F.lds + TAB_OFF), (const LAS int*)(F.lds + TAB_OFF) + 80, ltok, (const unsigned*)(F.ctl + CW_CNT), F.G, F.vcu};
        pg8::EpiSwiGLU E{HB};
        pg8::gemm_phase<pg8::EpiSwiGLU, pg8::GroupedOrder<4, true>, true>(F.lds, g, S, E);
    }
    SEAM(6);
    if (IN(7)) {
        build_tables(F);
        pg8::Gemm g{HB, Wd_t, DE};
        pg8::GroupedOrder<8, false> S{(const LAS int*)(F.lds + TAB_OFF), (const LAS int*)(F.lds + TAB_OFF) + 80, ltok, (const unsigned*)(F.ctl + CW_CNT), F.G, F.vcu};
        pg8::EpiScale E{YE, lwt};
        pg8::gemm_phase<pg8::EpiScale, pg8::GroupedOrder<8, false>, true>(F.lds, g, S, E);
    }
    SEAM(7);
    if (IN(8)) {
        build_tables(F);
        const LAS int* tstart = (const LAS int*)(F.lds + TAB_OFF);
        for (int grp = gw; grp < M / 16; grp += NGW) { const int r0 = grp * 16, b = r0 / SEQ; const float* g2 = mod + (size_t)b * (6 * D) + 5 * D;
            f32x4 gg[8], fg[8];
#pragma unroll
            for (int j = 0; j < 8; ++j) { gg[j] = ((const f32x4*)g2)[F.lane + 64 * j]; fg[j] = ((const f32x4*)final_g)[F.lane + 64 * j]; }
            for (int r = r0; r < r0 + 16; ++r) {
                const int4 ro = *(const int4*)(rout + (size_t)r * 4);
                const size_t s0 = (size_t)tstart[ro.x] * 256 + ro.z, s1 = (size_t)tstart[ro.y] * 256 + ro.w;
                const v2u* y0 = (const v2u*)(YE + s0 * D) + F.lane; const v2u* y1 = (const v2u*)(YE + s1 * D) + F.lane;
                f32x4* xr = (f32x4*)(out + (size_t)r * D) + F.lane;
                f32x4 v[8]; float s = 0.f;
#pragma unroll
                for (int j = 0; j < 8; ++j) { const v2u a = y0[64 * j], c = y1[64 * j]; const f32x4 xv = xr[64 * j];
                    const f32x4 ys = {bf_lo(a.x) + bf_lo(c.x), bf_hi(a.x) + bf_hi(c.x), bf_lo(a.y) + bf_lo(c.y), bf_hi(a.y) + bf_hi(c.y)};
                    v[j] = xv + gg[j] * ys; s += (v[j].x * v[j].x + v[j].y * v[j].y) + (v[j].z * v[j].z + v[j].w * v[j].w); }
                const float rstd = 1.0f / sqrtf(wave_sum(s) * (1.0f / D) + EPS);
#pragma unroll
                for (int j = 0; j < 8; ++j) xr[64 * j] = v[j] * rstd * fg[j];
            }
        }
    }
#undef IN
#undef SEAM
}

extern "C" void kernel_launch(void* const* d_in, const int* in_sizes, int n_in, void* d_out, int out_size, void* d_ws, size_t ws_size, hipStream_t stream) {
    static int grid = 0;
    if (grid == 0) {
        if (n_in != 26 || in_sizes[0] != M * D || out_size != M * D || ws_size < WS_END) { fprintf(stderr, "kernel_launch: unexpected shapes (n_in %d, in0 %d, out %d, ws %zu < %zu); nothing launched\n", n_in, n_in > 0 ? in_sizes[0] : -1, out_size, ws_size, (size_t)WS_END); grid = -1; return; }
        int dev = 0, cus = 0, per_cu = 0;
        if (hipGetDevice(&dev) != hipSuccess || hipDeviceGetAttribute(&cus, hipDeviceAttributeMultiprocessorCount, dev) != hipSuccess) { fprintf(stderr, "kernel_launch: device query failed\n"); grid = -1; return; }
        if (hipFuncSetAttribute((const void*)hybrid_fwd, hipFuncAttributeMaxDynamicSharedMemorySize, LDS_BYTES) != hipSuccess) { fprintf(stderr, "kernel_launch: hipFuncSetAttribute failed\n"); grid = -1; return; }
        if (hipOccupancyMaxActiveBlocksPerMultiprocessor(&per_cu, (const void*)hybrid_fwd, NWAVES * 64, LDS_BYTES) != hipSuccess || per_cu < 1) { fprintf(stderr, "kernel_launch: occupancy query reports %d workgroups per CU\n", per_cu); }
        (void)hipGetLastError();
        grid = cus;
        if (grid % 8 != 0 || grid < 8) { fprintf(stderr, "kernel_launch: grid %d not a multiple of 8\n", grid); grid = -1; return; }
    }
    if (grid < 0) return;
    if (hipMemsetAsync((char*)d_ws + WS_CTL, 0, CTL_ZERO_BYTES, stream) != hipSuccess) { fprintf(stderr, "kernel_launch: memset failed\n"); return; }
    Args a{};
    for (int i = 0; i < 26; ++i) a.in[i] = (const float*)d_in[i];
    a.out = (float*)d_out; a.ws = (unsigned char*)d_ws;
    for (int li = 0; li < MK_N_LAUNCHES; ++li) {
        a.ph_lo = (MK_N_LAUNCHES == 1) ? 0 : li; a.ph_hi = (MK_N_LAUNCHES == 1) ? N_PHASES : li + 1;
        hipLaunchKernelGGL(hybrid_fwd, dim3(grid), dim3(NWAVES * 64), LDS_BYTES, stream, a);
        const hipError_t le = hipPeekAtLastError();
        if (le != hipSuccess) { fprintf(stderr, "kernel_launch: launch %d failed: %s\n", li, hipGetErrorName(le)); break; }
    }
}
```

```cpp
#include <hip/hip_runtime.h>
#include <cstdio>
#include <cstdint>

#ifndef MK_N_LAUNCHES
#define MK_N_LAUNCHES 1
#endif

constexpr int D = 2048, NB = 16, SEQ = 2048, M = NB * SEQ;
constexpr int DC = 1024, DL = 1024, DIN = 5120;
constexpr int CONV_HD = 64, LRU_HEADS = 8, LRU_HD = 128;
constexpr int NE = 64, NGRP = 8, EPG = 8, DE = 512;
constexpr int NRC = 80;
constexpr float EPS = 1e-6f;
constexpr int MT_MAX = (2 * M) / 256 + NE;
constexpr int LISTCAP = M;

constexpr size_t MiB = 1u << 20;
constexpr size_t WS_CTL = 0, CTL_ZERO_BYTES = 1 * MiB;
constexpr size_t WS_MOD = 1 * MiB;
constexpr size_t WS_ROUT = 2 * MiB;
constexpr size_t WS_WR = 3 * MiB;
constexpr size_t WS_LTOK = 4 * MiB;
constexpr size_t WS_LW = 12 * MiB;
constexpr size_t WS_WIN = 20 * MiB;
constexpr size_t WS_WOUT = 40 * MiB;
constexpr size_t WS_WGU = 48 * MiB;
constexpr size_t WS_WD = 304 * MiB;
constexpr size_t WS_XN = 432 * MiB;
constexpr size_t WS_PROJ = 560 * MiB;
constexpr size_t WS_Y = 880 * MiB;
constexpr size_t WS_END = 1008 * MiB;
constexpr int CW_BAR = 4096;
constexpr int CW_CNT = 16384;

constexpr int RING_BYTES = 131072;
constexpr int LDSCTL_OFF = 143360;
constexpr int LDS_BYTES = 147456;
constexpr int MISC_OFF = LDSCTL_OFF;
constexpr int TAB_OFF = LDSCTL_OFF + 256;
constexpr int NWAVES = 8;

#define GAS __attribute__((address_space(1)))
#define LAS __attribute__((address_space(3)))
typedef unsigned short bf16;
typedef unsigned v4u __attribute__((ext_vector_type(4)));
typedef unsigned v2u __attribute__((ext_vector_type(2)));
typedef float f32x4 __attribute__((ext_vector_type(4)));
typedef float f32x2 __attribute__((ext_vector_type(2)));
typedef float f32x16 __attribute__((ext_vector_type(16)));
typedef short bf16x8 __attribute__((ext_vector_type(8)));
typedef __bf16 bf16x2_t __attribute__((ext_vector_type(2)));
typedef GAS unsigned gu32;
#define RLX_AGENT __ATOMIC_RELAXED, __HIP_MEMORY_SCOPE_AGENT
#define LDS_WAIT() asm volatile("s_waitcnt lgkmcnt(0)" ::: "memory")
#define VM_WAIT() asm volatile("s_waitcnt vmcnt(0)" ::: "memory")

__device__ __forceinline__ unsigned cvtpk(float lo, float hi) { f32x2 v = {lo, hi}; bf16x2_t b = __builtin_convertvector(v, bf16x2_t); return __builtin_bit_cast(unsigned, b); }
__device__ __forceinline__ float bf_lo(unsigned w) { return __builtin_bit_cast(float, w << 16); }
__device__ __forceinline__ float bf_hi(unsigned w) { return __builtin_bit_cast(float, w & 0xffff0000u); }
__device__ __forceinline__ float bf2f(bf16 b) { return __builtin_bit_cast(float, ((unsigned)b) << 16); }
__device__ __forceinline__ float fast_rcp(float x) { return __builtin_amdgcn_rcpf(x); }
__device__ __forceinline__ float fast_exp(float x) { return __builtin_amdgcn_exp2f(x * 1.44269504089f); }
__device__ __forceinline__ float fast_sqrt(float x) { return __builtin_amdgcn_sqrtf(x); }
__device__ __forceinline__ float fast_rsq(float x) { return __builtin_amdgcn_rsqf(x); }
__device__ __forceinline__ float sigmoidf_(float x) { return fast_rcp(1.0f + fast_exp(-x)); }
__device__ __forceinline__ float wave_sum(float v) {
#pragma unroll
    for (int o = 1; o < 64; o <<= 1) v += __shfl_xor(v, o);
    return v;
}

namespace pg8 {
constexpr int BM = 256, BK = 64, HALF = 128, HTB = HALF * BK * 2, STAGE_BYTES = 8 * HTB, NXCD = 8, WGM = 8;
__host__ __device__ __forceinline__ int lds_byte(int r, int c) { const int st = (r >> 4) * 2 + (c >> 5), rr = r & 15, cc = c & 31, ob = rr * 64 + cc * 2; return st * 1024 + (ob ^ (((ob >> 9) & 1) << 5)); }
__host__ __device__ __forceinline__ void stage_rc(int b, int& R, int& C) { const int st = b / 1024, sb = b % 1024, swz = sb ^ (((sb >> 9) & 1) << 5); R = (st >> 1) * 16 + swz / 64; C = (st & 1) * 32 + (swz % 64) / 2; }
__host__ __device__ __forceinline__ int perm32(int rho) { const int n = rho >> 4, i = rho & 15; return 8 * (i >> 2) + 4 * n + (i & 3); }

struct Unit { int pm, pn, e, r0, cnt, nt; };
struct Gemm { const bf16* A; const bf16* Bt; int K; };

struct StaticOrder {
    int nM, nN, nwg, G, c;
    __device__ void init(int M_, int N_, int G_, int c_) { nM = M_ / BM; nN = N_ / BM; nwg = nM * nN; G = G_; c = c_; }
    __device__ __forceinline__ bool next(int i, Unit& u) const {
        const long L = (long)i * G + c; if (L >= nwg) return false;
        int wgid = (int)L; { const int q = nwg / NXCD, r = nwg % NXCD, xcd = wgid % NXCD, off = wgid / NXCD; wgid = (xcd < r ? xcd * (q + 1) : r * (q + 1) + (xcd - r) * q) + off; }
        const int nig = WGM * nN, gid = wgid / nig, fm = gid * WGM, gsz = (nM - fm) < WGM ? (nM - fm) : WGM;
        u.pm = fm + ((wgid % nig) % gsz); u.pn = (wgid % nig) / gsz; u.e = 0; u.r0 = 0; u.cnt = 0; u.nt = 0; return true;
    }
    __device__ __forceinline__ void a_off(const Unit&, const int (&R)[2], const int (&C)[2], int K, unsigned (&o)[2][2]) const {
#pragma unroll
        for (int h = 0; h < 2; ++h)
#pragma unroll
            for (int i = 0; i < 2; ++i) o[h][i] = (unsigned)((h * HALF + R[i]) * K + C[i]) * 2u;
    }
    __device__ __forceinline__ const char* a_base(const Gemm& g, const Unit& u) const { return (const char*)g.A + (size_t)u.pm * ((size_t)BM * g.K * 2); }
};
template <int NT, bool GATHER> struct GroupedOrder {
    const LAS int* tstart; const LAS int* texp; const int* ltok; const unsigned* cnt; int G, vcu;
    __device__ __forceinline__ bool next(int i, Unit& u) const {
        const int total = tstart[NE] * NT;
        const int gx = G >> 3, x = vcu / gx, j = vcu % gx;
        const int per = (total + 7) >> 3, q = x * per + j + i * gx;
        if (j + i * gx >= per || q >= total) return false;
        const int mt = q / NT; u.nt = q % NT; u.pm = mt;
        const int e = __builtin_amdgcn_readfirstlane(texp[mt]); u.e = e; u.pn = e * NT + u.nt;
        u.r0 = (mt - __builtin_amdgcn_readfirstlane(tstart[e])) * BM;
        u.cnt = (int)__builtin_amdgcn_readfirstlane(__hip_atomic_load(cnt + 64 * e, RLX_AGENT));
        return true;
    }
    __device__ __forceinline__ void a_off(const Unit& u, const int (&R)[2], const int (&C)[2], int K, unsigned (&o)[2][2]) const {
#pragma unroll
        for (int h = 0; h < 2; ++h)
#pragma unroll
            for (int i = 0; i < 2; ++i) {
                if (GATHER) { const int rie = u.r0 + h * HALF + R[i]; const int tok = rie < u.cnt ? ltok[(size_t)u.e * LISTCAP + rie] : 0; o[h][i] = (unsigned)(tok * K + C[i]) * 2u; }
                else o[h][i] = (unsigned)((h * HALF + R[i]) * K + C[i]) * 2u;
            }
    }
    __device__ __forceinline__ const char* a_base(const Gemm& g, const Unit& u) const { return GATHER ? (const char*)g.A : (const char*)g.A + (size_t)u.pm * ((size_t)BM * g.K * 2); }
};

struct EpiBf16 {
    static constexpr bool PERM = true;
    bf16* O; int ldc;
    __device__ __forceinline__ void operator()(const f32x4 (&acc)[2][2][4][2], const Unit& u, int wr, int wc, int fr, int fq) const {
        const int row0 = u.pm * BM + wr * 64 + fr, col0 = u.pn * BM + wc * 32 + 8 * fq;
#pragma unroll
        for (int ai = 0; ai < 2; ++ai)
#pragma unroll
            for (int m = 0; m < 4; ++m) { bf16* rowp = O + (size_t)(row0 + ai * HALF + m * 16) * ldc + col0;
#pragma unroll
                for (int bj = 0; bj < 2; ++bj) { const f32x4 v0 = acc[ai][bj][m][0], v1 = acc[ai][bj][m][1];
                    v4u w; w.x = cvtpk(v0[0], v0[1]); w.y = cvtpk(v0[2], v0[3]); w.z = cvtpk(v1[0], v1[1]); w.w = cvtpk(v1[2], v1[3]);
                    *(v4u*)(rowp + bj * HALF) = w; } }
    }
};
struct EpiRes {
    static constexpr bool PERM = false;
    const float* x; float* out; const float* gate;
    __device__ __forceinline__ void operator()(const f32x4 (&acc)[2][2][4][2], const Unit& u, int wr, int wc, int fr, int fq) const {
        const int row0 = u.pm * BM + wr * 64 + fr, col0 = u.pn * BM + wc * 32 + 4 * fq;
        const float* gp = gate + (size_t)((u.pm * BM) / SEQ) * (6 * D) + col0;
        f32x4 gv[2][2];
#pragma unroll
        for (int bj = 0; bj < 2; ++bj)
#pragma unroll
            for (int n = 0; n < 2; ++n) gv[bj][n] = *(const f32x4*)(gp + bj * HALF + n * 16);
#pragma unroll
        for (int ai = 0; ai < 2; ++ai)
#pragma unroll
            for (int m = 0; m < 4; ++m) { const size_t off = (size_t)(row0 + ai * HALF + m * 16) * D + col0;
#pragma unroll
                for (int bj = 0; bj < 2; ++bj)
#pragma unroll
                    for (int n = 0; n < 2; ++n) { const f32x4 xs = *(const f32x4*)(x + off + bj * HALF + n * 16);
                        *(f32x4*)(out + off + bj * HALF + n * 16) = xs + gv[bj][n] * acc[ai][bj][m][n]; }
                asm volatile("" ::: "memory"); }
    }
};
struct EpiSwiGLU {
    static constexpr bool PERM = true;
    bf16* H;
    __device__ __forceinline__ void operator()(const f32x4 (&acc)[2][2][4][2], const Unit& u, int wr, int wc, int fr, int fq) const {
        const int row0 = u.pm * BM + wr * 64 + fr, col0 = u.nt * HALF + wc * 32 + 8 * fq;
#pragma unroll
        for (int ai = 0; ai < 2; ++ai)
#pragma unroll
            for (int m = 0; m < 4; ++m) { bf16* rowp = H + (size_t)(row0 + ai * HALF + m * 16) * DE + col0;
                float h[8];
#pragma unroll
                for (int n = 0; n < 2; ++n)
#pragma unroll
                    for (int j = 0; j < 4; ++j) { const float g = acc[ai][0][m][n][j], up = acc[ai][1][m][n][j]; h[n * 4 + j] = g * sigmoidf_(g) * up; }
                v4u w; w.x = cvtpk(h[0], h[1]); w.y = cvtpk(h[2], h[3]); w.z = cvtpk(h[4], h[5]); w.w = cvtpk(h[6], h[7]);
                *(v4u*)rowp = w; }
    }
};
struct EpiScale {
    static constexpr bool PERM = true;
    bf16* O; const float* lw;
    __device__ __forceinline__ void operator()(const f32x4 (&acc)[2][2][4][2], const Unit& u, int wr, int wc, int fr, int fq) const {
        const int rt0 = wr * 64 + fr, col0 = u.nt * BM + wc * 32 + 8 * fq;
        float wv[2][4];
#pragma unroll
        for (int ai = 0; ai < 2; ++ai)
#pragma unroll
            for (int m = 0; m < 4; ++m) { const int rie = u.r0 + rt0 + ai * HALF + m * 16; wv[ai][m] = rie < u.cnt ? lw[(size_t)u.e * LISTCAP + rie] : 0.f; }
#pragma unroll
        for (int ai = 0; ai < 2; ++ai)
#pragma unroll
            for (int m = 0; m < 4; ++m) { bf16* rowp = O + (size_t)(u.pm * BM + rt0 + ai * HALF + m * 16) * D + col0; const float s = wv[ai][m];
#pragma unroll
                for (int bj = 0; bj < 2; ++bj) { const f32x4 v0 = acc[ai][bj][m][0] * s, v1 = acc[ai][bj][m][1] * s;
                    v4u w; w.x = cvtpk(v0[0], v0[1]); w.y = cvtpk(v0[2], v0[3]); w.z = cvtpk(v1[0], v1[1]); w.w = cvtpk(v1[2], v1[3]);
                    *(v4u*)(rowp + bj * HALF) = w; } }
    }
};

template <class Epi, class Sched, bool ALIGN_EPI>
__device__ __forceinline__ void gemm_phase(LAS unsigned char* lds, const Gemm g, const Sched& S, const Epi& E) {
    const int tid = threadIdx.x, wid = __builtin_amdgcn_readfirstlane(tid >> 6), lane = tid & 63, wr = wid >> 2, wc = wid & 3, fr = lane & 15, fq = lane >> 4;
    const int K = g.K, nt = K / BK;
    int Rr[2], Cc[2]; unsigned voffB[2];
#pragma unroll
    for (int i = 0; i < 2; ++i) { int R, C; stage_rc(tid * 16 + i * 8192, R, C); const int Rb = Epi::PERM ? ((R & ~31) + perm32(R & 31)) : R; Rr[i] = R; Cc[i] = C; voffB[i] = (unsigned)(Rb * K + C) * 2u; }
    const size_t kstep = (size_t)(BK * 2);
    const size_t hstep = (size_t)HALF * K * 2;
    const size_t tstep = 2 * hstep;
    const unsigned ldsw = (unsigned)wid * 1024u;
    const int aoff = lds_byte(wr * 64 + fr, fq * 8), boff = lds_byte(wc * 32 + fr, fq * 8);
#define PG8_SA(b, h) (((b) * 2 + (h)) * HTB)
#define PG8_SB(b, h) ((4 + (b) * 2 + (h)) * HTB)
#define PG8_STAGE(bufoff, gbase, voff) do { _Pragma("unroll") for (int _i = 0; _i < 2; ++_i) \
        __builtin_amdgcn_global_load_lds((const unsigned*)((const char*)(gbase) + (voff)[_i]), (LAS unsigned*)(lds + (bufoff) + ldsw + _i * 8192), 16, 0, 0); } while (0)
#define PG8_LDA(dst, b, h) do { _Pragma("unroll") for (int m = 0; m < 4; ++m) _Pragma("unroll") for (int k = 0; k < 2; ++k) dst[m][k] = *(const LAS bf16x8*)(lds + PG8_SA(b, h) + aoff + m * 2048 + k * 1024); } while (0)
#define PG8_LDB(dst, b, h) do { _Pragma("unroll") for (int n = 0; n < 2; ++n) _Pragma("unroll") for (int k = 0; k < 2; ++k) dst[n][k] = *(const LAS bf16x8*)(lds + PG8_SB(b, h) + boff + n * 2048 + k * 1024); } while (0)
#define PG8_MMA(ai, bj, At, Bt) do { __builtin_amdgcn_s_setprio(1); _Pragma("unroll") for (int m = 0; m < 4; ++m) _Pragma("unroll") for (int n = 0; n < 2; ++n) _Pragma("unroll") for (int k = 0; k < 2; ++k) \
        acc[ai][bj][m][n] = __builtin_amdgcn_mfma_f32_16x16x32_bf16(Bt[n][k], At[m][k], acc[ai][bj][m][n], 0, 0, 0); __builtin_amdgcn_s_setprio(0); } while (0)
#define PG8_WAIT_V(n) asm volatile("s_waitcnt vmcnt(" #n ")" ::: "memory")
#define PG8_WAIT_L(n) asm volatile("s_waitcnt lgkmcnt(" #n ")" ::: "memory")
#define PG8_BAR __builtin_amdgcn_s_barrier()
#define PG8_SCHED __builtin_amdgcn_sched_barrier(0)
    Unit cur, nxt; int ui = 0;
    if (!S.next(0, cur)) return;
    f32x4 acc[2][2][4][2];
#pragma unroll
    for (int a = 0; a < 2; ++a)
#pragma unroll
        for (int b = 0; b < 2; ++b)
#pragma unroll
            for (int m = 0; m < 4; ++m)
#pragma unroll
                for (int n = 0; n < 2; ++n) acc[a][b][m][n] = (f32x4){0.f, 0.f, 0.f, 0.f};
    bf16x8 At[4][2], B0[2][2], B1[2][2];
    unsigned cO[2][2], nO[2][2];
    S.a_off(cur, Rr, Cc, K, cO);
    const char* cA = S.a_base(g, cur); const char* cB = (const char*)g.Bt + (size_t)cur.pn * tstep;
    PG8_STAGE(PG8_SB(0, 0), cB, voffB); PG8_STAGE(PG8_SB(0, 1), cB + hstep, voffB); PG8_STAGE(PG8_SA(0, 0), cA, cO[0]); PG8_STAGE(PG8_SA(0, 1), cA, cO[1]);
    if (wr == 1) PG8_BAR;
    PG8_WAIT_V(2); PG8_BAR;
    PG8_STAGE(PG8_SB(1, 0), cB + kstep, voffB); PG8_STAGE(PG8_SA(1, 0), cA + kstep, cO[0]); PG8_STAGE(PG8_SB(1, 1), cB + hstep + kstep, voffB);
    PG8_WAIT_V(6); PG8_BAR;
    for (;;) {
        const bool has_next = S.next(ui + 1, nxt);
        const char* nA = cA; const char* nB = cB;
#pragma unroll
        for (int h = 0; h < 2; ++h)
#pragma unroll
            for (int i = 0; i < 2; ++i) nO[h][i] = cO[h][i];
        if (has_next) { S.a_off(nxt, Rr, Cc, K, nO); nA = S.a_base(g, nxt); nB = (const char*)g.Bt + (size_t)nxt.pn * tstep; }
        for (int t = 0; t < nt; t += 2) {
            const bool last = (t == nt - 2);
            const char* a1 = cA + (size_t)(t + 1) * kstep;
            const char* a2 = last ? nA : cA + (size_t)(t + 2) * kstep; const char* b2 = last ? nB : cB + (size_t)(t + 2) * kstep;
            const char* a3 = a2 + kstep; const char* b3 = b2 + kstep;
            unsigned o2[2][2];
#pragma unroll
            for (int h = 0; h < 2; ++h)
#pragma unroll
                for (int i = 0; i < 2; ++i) o2[h][i] = last ? nO[h][i] : cO[h][i];
            PG8_LDB(B0, 0, 0); PG8_LDB(B1, 0, 1); PG8_SCHED; PG8_LDA(At, 0, 0); PG8_STAGE(PG8_SA(1, 1), a1, cO[1]);
            PG8_WAIT_V(8); PG8_WAIT_L(0); PG8_BAR; PG8_MMA(0, 0, At, B0); PG8_MMA(0, 1, At, B1); PG8_BAR; PG8_SCHED;
            PG8_LDA(At, 0, 1); PG8_STAGE(PG8_SB(0, 0), b2, voffB); PG8_STAGE(PG8_SB(0, 1), b2 + hstep, voffB); PG8_STAGE(PG8_SA(0, 0), a2, o2[0]);
            PG8_WAIT_V(8); PG8_WAIT_L(0); PG8_BAR; PG8_MMA(1, 0, At, B0); PG8_MMA(1, 1, At, B1); PG8_BAR; PG8_SCHED;
            PG8_LDB(B0, 1, 0); PG8_LDB(B1, 1, 1); PG8_SCHED; PG8_LDA(At, 1, 0); PG8_STAGE(PG8_SA(0, 1), a2, o2[1]);
            PG8_WAIT_V(8); PG8_WAIT_L(0); PG8_BAR; PG8_MMA(0, 0, At, B0); PG8_MMA(0, 1, At, B1); PG8_BAR; PG8_SCHED;
            PG8_LDA(At, 1, 1); PG8_STAGE(PG8_SB(1, 0), b3, voffB); PG8_STAGE(PG8_SB(1, 1), b3 + hstep, voffB); PG8_STAGE(PG8_SA(1, 0), a3, o2[0]);
            PG8_WAIT_V(8); PG8_WAIT_L(0); PG8_BAR; PG8_MMA(1, 0, At, B0); PG8_MMA(1, 1, At, B1); PG8_BAR; PG8_SCHED;
        }
        if constexpr (ALIGN_EPI) { if (wr == 0) PG8_BAR; }
        E(acc, cur, wr, wc, fr, fq);
        if (!has_next) break;
#pragma unroll
        for (int a = 0; a < 2; ++a)
#pragma unroll
            for (int b = 0; b < 2; ++b)
#pragma unroll
                for (int m = 0; m < 4; ++m)
#pragma unroll
                    for (int n = 0; n < 2; ++n) acc[a][b][m][n] = (f32x4){0.f, 0.f, 0.f, 0.f};
        cur = nxt; cA = nA; cB = nB; ++ui;
#pragma unroll
        for (int h = 0; h < 2; ++h)
#pragma unroll
            for (int i = 0; i < 2; ++i) cO[h][i] = nO[h][i];
        if constexpr (ALIGN_EPI) { if (wr == 1) PG8_BAR; }
    }
    PG8_WAIT_V(0);
    if constexpr (!ALIGN_EPI) { if (wr == 0) PG8_BAR; }
    PG8_BAR;
#undef PG8_SA
#undef PG8_SB
#undef PG8_STAGE
#undef PG8_LDA
#undef PG8_LDB
#undef PG8_MMA
#undef PG8_WAIT_V
#undef PG8_WAIT_L
#undef PG8_BAR
#undef PG8_SCHED
}
}

#define XB_TMO      128
#define XB_XCNT(j)  (256  + 64 * (j))
#define XB_XSUB(j)  (1280 + 64 * (j))
#define XB_XGEN(j)  (2304 + 64 * (j))
#define XB_TOP      3328
#define XB_TOPGEN   3392
#define XCD_BAR_WORDS 3456
#define XB_SPIN_CAP (1u << 18)
__device__ __forceinline__ unsigned xb_ld(unsigned* p)              { return __hip_atomic_load(p, __ATOMIC_RELAXED, __HIP_MEMORY_SCOPE_AGENT); }
__device__ __forceinline__ unsigned xb_add(unsigned* p, unsigned v) { return __hip_atomic_fetch_add(p, v, __ATOMIC_RELAXED, __HIP_MEMORY_SCOPE_AGENT); }
__device__ __forceinline__ unsigned xb_xcc_id() { return (unsigned)__builtin_amdgcn_s_getreg((3 << 11) | 20) & 0xFu; }
#define XB_SPIN(cond, bar) do { unsigned _sp = 0; while (cond) { __builtin_amdgcn_s_sleep(1); \
    if ((++_sp & 255u) == 0u) { if (xb_ld(&(bar)[XB_TMO])) break; if (_sp > XB_SPIN_CAP) { atomicAdd(&(bar)[XB_TMO], 1u); break; } } } } while (0)
struct XcdBarrier { unsigned* bar; unsigned x; volatile LAS unsigned* st; };
__device__ __forceinline__ XcdBarrier xcd_barrier_post(unsigned* bar, volatile LAS unsigned* st) {
    XcdBarrier b; b.bar = bar; b.x = xb_xcc_id(); b.st = st;
    if (threadIdx.x == 0) (void)xb_add(&bar[XB_XCNT(b.x)], 1u);
    return b;
}
__device__ __forceinline__ void xcd_barrier_complete(unsigned* bar, unsigned x, unsigned& nloc, unsigned& nx) {
    const unsigned G = gridDim.x * gridDim.y * gridDim.z;
    unsigned sum, cnt, mine, sp = 0u;
    for (;;) {
        sum = 0u; cnt = 0u; mine = 0u;
#pragma unroll
        for (unsigned j = 0; j < 16; ++j) { const unsigned c = xb_ld(&bar[XB_XCNT(j)]); sum += c; cnt += (c > 0u) ? 1u : 0u; mine = (j == x) ? c : mine; }
        if (sum == G) break;
        __builtin_amdgcn_s_sleep(1);
        if ((++sp & 255u) == 0u) { if (xb_ld(&bar[XB_TMO])) break; if (sp > XB_SPIN_CAP) { atomicAdd(&bar[XB_TMO], 1u); break; } }
    }
    nloc = mine > 0u ? mine : 1u; nx = cnt > 0u ? cnt : 1u;
}
__device__ __forceinline__ void xcd_barrier(const XcdBarrier& b) {
    asm volatile("s_waitcnt vmcnt(0)" ::: "memory");
    __syncthreads();
    if (threadIdx.x == 0) {
        unsigned* bar = b.bar;
        __builtin_amdgcn_s_waitcnt(0);
        unsigned nloc = b.st[0], nx = b.st[1];
        if (nloc == 0u) { xcd_barrier_complete(bar, b.x, nloc, nx); b.st[0] = nloc; b.st[1] = nx; }
        const unsigned old = xb_add(&bar[XB_XSUB(b.x)], 1u);
        const unsigned gen = old / nloc;
        if (old + 1u == (gen + 1u) * nloc) {
            __builtin_amdgcn_fence(__ATOMIC_RELEASE, "agent");
            asm volatile("s_waitcnt vmcnt(0)" ::: "memory");
            const unsigned og = xb_add(&bar[XB_TOP], 1u);
            const unsigned tg = og / nx;
            if (og + 1u == (tg + 1u) * nx) xb_add(&bar[XB_TOPGEN], 1u);
            else XB_SPIN(xb_ld(&bar[XB_TOPGEN]) == tg, bar);
            __builtin_amdgcn_fence(__ATOMIC_ACQUIRE, "agent");
            xb_add(&bar[XB_XGEN(b.x)], 1u);
            asm volatile("s_waitcnt vmcnt(0)" ::: "memory");
        } else {
            XB_SPIN(xb_ld(&bar[XB_XGEN(b.x)]) == gen, bar);
            __builtin_amdgcn_fence(__ATOMIC_ACQUIRE, "agent");
            asm volatile("s_waitcnt vmcnt(0)" ::: "memory");
        }
    }
    __syncthreads();
}

struct Frame {
    LAS unsigned char* lds;
    volatile LAS unsigned* MISC;
    gu32* ctl;
    int tid, lane, wave, vcu, G;
};
struct Args {
    const float* in[26]; float* out; unsigned char* ws; int ph_lo, ph_hi;
};

__device__ __forceinline__ void p0_transpose_item(const float* W, int N, int k0, int n0, bf16* WT, size_t drow0, int Kd, LAS float* scr, int lane) {
    const int lq = lane & 15, lk = lane >> 4;
#pragma unroll 8
    for (int i = 0; i < 16; ++i) { const int kk = 4 * i + lk; const f32x4 v = *(const f32x4*)(W + (size_t)(k0 + kk) * N + n0 + 4 * lq);
        LAS float* s = scr + kk * 65 + 4 * lq; s[0] = v.x; s[1] = v.y; s[2] = v.z; s[3] = v.w; }
    LDS_WAIT(); asm volatile("" ::: "memory");
    const int c = lane & 7;
#pragma unroll
    for (int j = 0; j < 8; ++j) { const int n = (lane >> 3) + 8 * j; const LAS float* s = scr + (8 * c) * 65 + n;
        v4u o; o.x = cvtpk(s[0 * 65], s[1 * 65]); o.y = cvtpk(s[2 * 65], s[3 * 65]); o.z = cvtpk(s[4 * 65], s[5 * 65]); o.w = cvtpk(s[6 * 65], s[7 * 65]);
        *(v4u*)(WT + (drow0 + n) * (size_t)Kd + k0 + 8 * c) = o; }
    LDS_WAIT(); asm volatile("" ::: "memory");
}
__device__ __forceinline__ void p0_mod_unit(Frame& F, const float* c, const float* ada_w, const float* ada_b, float* mod, int unit) {
    const int n0 = unit * 64, lane = F.lane, w = F.wave, k0 = w * 256;
    LAS float* sc = (LAS float*)(F.lds + w * 16384);
    for (int b = 0; b < NB; ++b)
#pragma unroll
        for (int j = 0; j < 4; ++j) { const float v = c[(size_t)b * D + k0 + 64 * j + lane]; sc[(64 * j + lane) * 16 + b] = v * sigmoidf_(v); }
    LDS_WAIT(); asm volatile("" ::: "memory");
    float acc[NB][4];
#pragma unroll
    for (int b = 0; b < NB; ++b)
#pragma unroll
        for (int j = 0; j < 4; ++j) acc[b][j] = 0.f;
    const int lq = lane & 15, lk = lane >> 4;
#pragma unroll 4
    for (int i = 0; i < 64; ++i) { const int kk = 4 * i + lk; const f32x4 wv = *(const f32x4*)(ada_w + (size_t)(k0 + kk) * (6 * D) + n0 + 4 * lq);
        const LAS f32x4* sp = (const LAS f32x4*)(sc + kk * 16);
#pragma unroll
        for (int q = 0; q < 4; ++q) { const f32x4 s4 = sp[q];
#pragma unroll
            for (int bb = 0; bb < 4; ++bb)
#pragma unroll
                for (int j = 0; j < 4; ++j) acc[q * 4 + bb][j] += s4[bb] * wv[j]; } }
    LDS_WAIT(); asm volatile("" ::: "memory");
    LAS f32x4* rp = (LAS f32x4*)(F.lds + w * 16384) + lane * 16;
#pragma unroll
    for (int b = 0; b < NB; ++b) rp[b] = (f32x4){acc[b][0], acc[b][1], acc[b][2], acc[b][3]};
    LDS_WAIT(); __syncthreads();
    for (int o = F.tid; o < NB * 64; o += NWAVES * 64) { const int b = o >> 6, n = o & 63, q = n >> 2, j = n & 3; float s = 0.f;
#pragma unroll
        for (int ww = 0; ww < 8; ++ww)
#pragma unroll
            for (int gq = 0; gq < 4; ++gq) s += ((const LAS float*)(F.lds + ww * 16384))[(gq * 16 + q) * 64 + b * 4 + j];
        mod[(size_t)b * (6 * D) + n0 + n] = s + ada_b[n0 + n]; }
    LDS_WAIT(); __syncthreads();
}

__device__ __forceinline__ void modnorm_rows(Frame& F, const float* xin, bf16* xn, const float* gain, const float* shift, const float* scale, int r0, int nrows) {
    f32x4 mu[8], ad[8];
#pragma unroll
    for (int j = 0; j < 8; ++j) { const f32x4 g = ((const f32x4*)gain)[F.lane + 64 * j], sc = ((const f32x4*)scale)[F.lane + 64 * j]; mu[j] = g * (1.0f + sc); ad[j] = ((const f32x4*)shift)[F.lane + 64 * j]; }
    for (int r = r0; r < r0 + nrows; ++r) {
        const f32x4* xr = (const f32x4*)(xin + (size_t)r * D) + F.lane;
        f32x4 v[8]; float s = 0.f;
#pragma unroll
        for (int j = 0; j < 8; ++j) { v[j] = xr[64 * j]; s += (v[j].x * v[j].x + v[j].y * v[j].y) + (v[j].z * v[j].z + v[j].w * v[j].w); }
        const float rstd = 1.0f / sqrtf(wave_sum(s) * (1.0f / D) + EPS);
        v2u* o8 = (v2u*)(xn + (size_t)r * D) + F.lane;
#pragma unroll
        for (int j = 0; j < 8; ++j) { const f32x4 h = v[j] * rstd * mu[j] + ad[j]; v2u w; w.x = cvtpk(h.x, h.y); w.y = cvtpk(h.z, h.w); o8[64 * j] = w; }
    }
}

__device__ __forceinline__ float gelu_tanh(float x) {
    const float t = 1.5957691216f * (x + 0.044715f * x * x * x);
    return x * sigmoidf_(t);
}
__device__ __forceinline__ void mixer_a_unit(Frame& F, const bf16* proj, bf16* Y, const float* conv3_w, const float* gconv, int ua) {
    const int ch0 = (F.wave & 1) * 512 + F.lane * 8, t0 = ua * 256 + (F.wave >> 1) * 64;
    float w0[8], w1[8], w2[8], gg[8];
#pragma unroll
    for (int j = 0; j < 8; ++j) { w0[j] = conv3_w[ch0 + j]; w1[j] = conv3_w[DC + ch0 + j]; w2[j] = conv3_w[2 * DC + ch0 + j]; gg[j] = gconv[ch0 + j]; }
    float u1[8], u2[8];
    const bool hist = (t0 % SEQ) != 0;
    {
        v4u c1 = {0, 0, 0, 0}, x1 = {0, 0, 0, 0}, c2 = {0, 0, 0, 0}, x2 = {0, 0, 0, 0};
        if (hist) { const bf16* p1 = proj + (size_t)(t0 - 1) * DIN + ch0; const bf16* p2 = proj + (size_t)(t0 - 2) * DIN + ch0;
            c1 = *(const v4u*)(p1 + DC); x1 = *(const v4u*)(p1 + 2 * DC); c2 = *(const v4u*)(p2 + DC); x2 = *(const v4u*)(p2 + 2 * DC); }
#pragma unroll
        for (int q = 0; q < 4; ++q) { u1[2 * q] = bf_lo(c1[q]) * bf_lo(x1[q]); u1[2 * q + 1] = bf_hi(c1[q]) * bf_hi(x1[q]); u2[2 * q] = bf_lo(c2[q]) * bf_lo(x2[q]); u2[2 * q + 1] = bf_hi(c2[q]) * bf_hi(x2[q]); }
    }
#pragma unroll 4
    for (int t = t0; t < t0 + 64; ++t) {
        const bf16* p = proj + (size_t)t * DIN + ch0;
        const v4u bv = *(const v4u*)p, cv = *(const v4u*)(p + DC), xv = *(const v4u*)(p + 2 * DC);
        float y[8]; float ss = 0.f;
#pragma unroll
        for (int q = 0; q < 4; ++q) {
            const float ua0 = bf_lo(cv[q]) * bf_lo(xv[q]), ub0 = bf_hi(cv[q]) * bf_hi(xv[q]);
            const float va = w0[2 * q] * u2[2 * q] + w1[2 * q] * u1[2 * q] + w2[2 * q] * ua0;
            const float vb = w0[2 * q + 1] * u2[2 * q + 1] + w1[2 * q + 1] * u1[2 * q + 1] + w2[2 * q + 1] * ub0;
            u2[2 * q] = u1[2 * q]; u1[2 * q] = ua0; u2[2 * q + 1] = u1[2 * q + 1]; u1[2 * q + 1] = ub0;
            y[2 * q] = bf_lo(bv[q]) * va; y[2 * q + 1] = bf_hi(bv[q]) * vb;
            ss += y[2 * q] * y[2 * q] + y[2 * q + 1] * y[2 * q + 1];
        }
        ss += __shfl_xor(ss, 1); ss += __shfl_xor(ss, 2); ss += __shfl_xor(ss, 4);
        const float rstd = fast_rsq(ss * (1.0f / CONV_HD) + EPS);
        v4u o;
#pragma unroll
        for (int q = 0; q < 4; ++q) o[q] = cvtpk(y[2 * q] * rstd * gg[2 * q], y[2 * q + 1] * rstd * gg[2 * q + 1]);
        *(v4u*)(Y + (size_t)t * D + ch0) = o;
    }
}
constexpr int MB_TB = 128, MB_PITCH = 272;
constexpr int MB_XI = 0, MB_ST = MB_TB * MB_PITCH, MB_SS = 2 * MB_TB * MB_PITCH, MB_C4 = MB_SS + 8 * MB_TB * 4, MB_END = MB_C4 + 5 * 128 * 4;
static_assert(MB_END <= LDSCTL_OFF, "mixer B LDS");
__device__ __forceinline__ void mixer_b_unit(Frame& F, const bf16* proj, bf16* Y, const float* conv4_w, const float* conv4_b, const float* lru_w_a, const float* lru_b_a,
                                             const float* lru_w_x, const float* lru_b_x, const float* lam, const float* glru, int unit) {
    const int b = unit >> 3, hd = unit & 7, lane = F.lane, w = F.wave, c = lane & 15, kg = lane >> 4;
    LAS float* C4 = (LAS float*)(F.lds + MB_C4);
    __syncthreads();
    for (int idx = F.tid; idx < 5 * 128; idx += NWAVES * 64) { const int tap = idx >> 7, ch = idx & 127; C4[idx] = tap < 4 ? conv4_w[tap * DL + hd * 128 + ch] : conv4_b[hd * 128 + ch]; }
    bf16x8 fa[4], fx[4];
#pragma unroll
    for (int ks = 0; ks < 4; ++ks) { float ta[8], tx[8];
#pragma unroll
        for (int j = 0; j < 8; ++j) { const size_t o = (size_t)hd * 16384 + (size_t)(32 * ks + 8 * kg + j) * 128 + 16 * w + c; ta[j] = lru_w_a[o]; tx[j] = lru_w_x[o]; }
        v4u pa, px; pa.x = cvtpk(ta[0], ta[1]); pa.y = cvtpk(ta[2], ta[3]); pa.z = cvtpk(ta[4], ta[5]); pa.w = cvtpk(ta[6], ta[7]);
        px.x = cvtpk(tx[0], tx[1]); px.y = cvtpk(tx[2], tx[3]); px.z = cvtpk(tx[4], tx[5]); px.w = cvtpk(tx[6], tx[7]);
        fa[ks] = __builtin_bit_cast(bf16x8, pa); fx[ks] = __builtin_bit_cast(bf16x8, px); }
    bf16x8 idn;
#pragma unroll
    for (int j = 0; j < 8; ++j) idn[j] = (8 * kg + j == 16 * (w & 1) + c) ? (short)0x3f80 : (short)0;
    const int ch = hd * 128 + 16 * w + c;
    const float ba = lru_b_a[ch], bx = lru_b_x[ch], nsp = -8.0f * log1pf(expf(-lam[ch]));
    const int pc = F.tid & 15, tg = F.tid >> 4;
    float gl8[8];
#pragma unroll
    for (int j = 0; j < 8; ++j) gl8[j] = glru[hd * 128 + pc * 8 + j];
    LAS unsigned char* xi_w = F.lds + MB_XI + (4 * tg) * MB_PITCH + pc * 16;
    LAS unsigned char* xi_r = F.lds + MB_XI + c * MB_PITCH + kg * 16;
    LAS unsigned char* st_w = F.lds + MB_ST + (4 * kg) * MB_PITCH + (16 * w + c) * 2;
    LAS float* ss_w = (LAS float*)(F.lds + MB_SS) + w * MB_TB + 4 * kg;
    LAS unsigned char* c4l = F.lds + MB_C4 + pc * 32;
    asm volatile("" : "+v"(xi_w), "+v"(xi_r), "+v"(st_w), "+v"(ss_w), "+v"(c4l));
    const bf16* xb = proj + (size_t)b * SEQ * DIN + 4 * 1024 + hd * 128 + pc * 8;
    const bf16* gb = proj + (size_t)b * SEQ * DIN + 3 * 1024 + hd * 128 + 32 * (w >> 1) + 8 * kg;
    bf16* yo = Y + (size_t)b * SEQ * D + DC + hd * 128 + pc * 8;
    float hc = 0.f;
    LDS_WAIT(); __syncthreads();
#pragma unroll 1
    for (int tb = 0; tb < SEQ / MB_TB; ++tb) {
        const int t0 = tb * MB_TB;
        {
            float wt[4][8], bs[8];
#pragma unroll
            for (int tap = 0; tap < 4; ++tap) { const LAS f32x4* wp = (const LAS f32x4*)(c4l + tap * 512); const f32x4 wa = wp[0], wb = wp[1];
                wt[tap][0] = wa.x; wt[tap][1] = wa.y; wt[tap][2] = wa.z; wt[tap][3] = wa.w; wt[tap][4] = wb.x; wt[tap][5] = wb.y; wt[tap][6] = wb.z; wt[tap][7] = wb.w; }
            { const LAS f32x4* wp = (const LAS f32x4*)(c4l + 4 * 512); const f32x4 wa = wp[0], wb = wp[1]; bs[0] = wa.x; bs[1] = wa.y; bs[2] = wa.z; bs[3] = wa.w; bs[4] = wb.x; bs[5] = wb.y; bs[6] = wb.z; bs[7] = wb.w; }
            v4u rows[7];
#pragma unroll
            for (int i = 0; i < 7; ++i) { const int tt = t0 + 4 * tg - 3 + i; rows[i] = (v4u){0, 0, 0, 0}; if (tt >= 0) rows[i] = *(const v4u*)(xb + (size_t)tt * DIN); }
#pragma unroll
            for (int i = 0; i < 4; ++i) { float xc[8];
#pragma unroll
                for (int j = 0; j < 8; ++j) xc[j] = bs[j];
#pragma unroll
                for (int tap = 0; tap < 4; ++tap) { const v4u v = rows[i + tap];
                    xc[0] += wt[tap][0] * bf_lo(v.x); xc[1] += wt[tap][1] * bf_hi(v.x); xc[2] += wt[tap][2] * bf_lo(v.y); xc[3] += wt[tap][3] * bf_hi(v.y);
                    xc[4] += wt[tap][4] * bf_lo(v.z); xc[5] += wt[tap][5] * bf_hi(v.z); xc[6] += wt[tap][6] * bf_lo(v.w); xc[7] += wt[tap][7] * bf_hi(v.w); }
                v4u p; p.x = cvtpk(xc[0], xc[1]); p.y = cvtpk(xc[2], xc[3]); p.z = cvtpk(xc[4], xc[5]); p.w = cvtpk(xc[6], xc[7]);
                *(LAS v4u*)(xi_w + i * MB_PITCH) = p; }
        }
        LDS_WAIT(); __syncthreads();
#pragma unroll 1
        for (int s = 0; s < MB_TB / 16; ++s) {
            const bf16x8 gfr = *(const bf16x8*)(gb + (size_t)(t0 + 16 * s + c) * DIN);
            f32x4 ar = {0.f, 0.f, 0.f, 0.f}, ai = ar, ax = ar, ag = ar;
            const LAS unsigned char* xr = xi_r + s * (16 * MB_PITCH);
#pragma unroll
            for (int ks = 0; ks < 4; ++ks) { const bf16x8 af = *(const LAS bf16x8*)(xr + ks * 64);
                ar = __builtin_amdgcn_mfma_f32_16x16x32_bf16(af, fa[ks], ar, 0, 0, 0);
                ai = __builtin_amdgcn_mfma_f32_16x16x32_bf16(af, fx[ks], ai, 0, 0, 0); }
            { const bf16x8 af = *(const LAS bf16x8*)(xr + (w >> 1) * 64); ax = __builtin_amdgcn_mfma_f32_16x16x32_bf16(af, idn, ax, 0, 0, 0); }
            ag = __builtin_amdgcn_mfma_f32_16x16x32_bf16(gfr, idn, ag, 0, 0, 0);
            float Hl[4], Pl[4]; float h = 0.f, P = 1.f;
#pragma unroll
            for (int v = 0; v < 4; ++v) {
                const float r = sigmoidf_(ar[v] + ba), ig = sigmoidf_(ai[v] + bx);
                const float la = nsp * r, a = fast_exp(la), z = 2.0f * la;
                const float em1 = z * (1.0f + z * (0.5f + z * (0.16666667f + z * (0.041666668f + z * 0.0083333333f))));
                const float om = (z > -0.35f) ? -em1 : 1.0f - fast_exp(z);
                const float u = fast_sqrt(om) * ig * ax[v];
                h = a * h + u; P *= a; Hl[v] = h; Pl[v] = P; }
            float X = hc, Xn = hc;
#pragma unroll
            for (int g = 0; g < 4; ++g) { const float pg = __shfl(P, c + 16 * g), hg = __shfl(h, c + 16 * g); if (g == kg) X = Xn; Xn = pg * Xn + hg; }
            hc = Xn;
            float yb[4]; f32x4 ss;
#pragma unroll
            for (int v = 0; v < 4; ++v) { const float hv = Pl[v] * X + Hl[v]; yb[v] = hv * gelu_tanh(ag[v]); ss[v] = yb[v] * yb[v]; }
#pragma unroll
            for (int o = 1; o < 16; o <<= 1) { ss[0] += __shfl_xor(ss[0], o); ss[1] += __shfl_xor(ss[1], o); ss[2] += __shfl_xor(ss[2], o); ss[3] += __shfl_xor(ss[3], o); }
            if (c == 0) *(LAS f32x4*)(ss_w + 16 * s) = ss;
#pragma unroll
            for (int v = 0; v < 4; ++v) *(LAS bf16*)(st_w + (16 * s + v) * MB_PITCH) = (bf16)(cvtpk(yb[v], 0.f) & 0xffffu);
        }
        LDS_WAIT(); __syncthreads();
#pragma unroll
        for (int i = 0; i < 4; ++i) { const int tk = 4 * tg + i; float sq = 0.f;
#pragma unroll
            for (int ww = 0; ww < 8; ++ww) sq += ((const LAS float*)(F.lds + MB_SS))[ww * MB_TB + tk];
            const float rstd = fast_rsq(sq * (1.0f / LRU_HD) + EPS);
            const v4u p = *(const LAS v4u*)(xi_w + (MB_ST - MB_XI) + i * MB_PITCH);
            v4u o; o.x = cvtpk(bf_lo(p.x) * rstd * gl8[0], bf_hi(p.x) * rstd * gl8[1]); o.y = cvtpk(bf_lo(p.y) * rstd * gl8[2], bf_hi(p.y) * rstd * gl8[3]);
            o.z = cvtpk(bf_lo(p.z) * rstd * gl8[4], bf_hi(p.z) * rstd * gl8[5]); o.w = cvtpk(bf_lo(p.w) * rstd * gl8[6], bf_hi(p.w) * rstd * gl8[7]);
            *(v4u*)(yo + (size_t)(t0 + tk) * D) = o; }
    }
    __syncthreads();
}

constexpr int P5_ROWB = 4112;
constexpr int P5_HI = 0, P5_LO = 16 * P5_ROWB, P5_END = 2 * 16 * P5_ROWB;
static_assert(P5_END <= LDSCTL_OFF && 8 * 16 * NRC * 4 <= P5_END, "P5 LDS");
__device__ __forceinline__ void p5_pass(Frame& F, const float* x1, bf16* xn, const f32x4 (&mu)[8], const f32x4 (&ad)[8], const bf16* wr_hi, const bf16* wr_lo,
                                        const float* rbg, const float* rbe, int row0, int* rout, int* ltok, float* lwt) {
    const int lane = F.lane, w = F.wave;
#pragma unroll 1
    for (int rr = 0; rr < 2; ++rr) { const int lr = 2 * w + rr, r = row0 + lr;
        const f32x4* xr = (const f32x4*)(x1 + (size_t)r * D) + lane;
        f32x4 v[8]; float s = 0.f;
#pragma unroll
        for (int j = 0; j < 8; ++j) { v[j] = xr[64 * j]; s += (v[j].x * v[j].x + v[j].y * v[j].y) + (v[j].z * v[j].z + v[j].w * v[j].w); }
        const float rstd = 1.0f / sqrtf(wave_sum(s) * (1.0f / D) + EPS);
        v2u* o8 = (v2u*)(xn + (size_t)r * D) + lane;
#pragma unroll
        for (int j = 0; j < 8; ++j) { const f32x4 h = v[j] * rstd * mu[j] + ad[j]; v2u hi; hi.x = cvtpk(h.x, h.y); hi.y = cvtpk(h.z, h.w); o8[64 * j] = hi;
            v2u lo; lo.x = cvtpk(h.x - bf_lo(hi.x), h.y - bf_hi(hi.x)); lo.y = cvtpk(h.z - bf_lo(hi.y), h.w - bf_hi(hi.y));
            *(LAS v2u*)(F.lds + P5_HI + lr * P5_ROWB + (lane + 64 * j) * 8) = hi; *(LAS v2u*)(F.lds + P5_LO + lr * P5_ROWB + (lane + 64 * j) * 8) = lo; }
    }
    LDS_WAIT(); __syncthreads();
    const int fr = lane & 15, fq = lane >> 4;
    f32x4 acc[5];
#pragma unroll
    for (int t = 0; t < 5; ++t) acc[t] = (f32x4){0.f, 0.f, 0.f, 0.f};
#pragma unroll 1
    for (int ks = 0; ks < 8; ++ks) { const int k = w * 256 + ks * 32 + 8 * fq;
        const bf16x8 ah = *(const LAS bf16x8*)(F.lds + P5_HI + fr * P5_ROWB + k * 2), al = *(const LAS bf16x8*)(F.lds + P5_LO + fr * P5_ROWB + k * 2);
#pragma unroll
        for (int t = 0; t < 5; ++t) { const bf16x8 bh = *(const bf16x8*)(wr_hi + (size_t)(t * 16 + fr) * D + k), bl = *(const bf16x8*)(wr_lo + (size_t)(t * 16 + fr) * D + k);
            acc[t] = __builtin_amdgcn_mfma_f32_16x16x32_bf16(ah, bh, acc[t], 0, 0, 0);
            acc[t] = __builtin_amdgcn_mfma_f32_16x16x32_bf16(ah, bl, acc[t], 0, 0, 0);
            acc[t] = __builtin_amdgcn_mfma_f32_16x16x32_bf16(al, bh, acc[t], 0, 0, 0); } }
    LDS_WAIT(); __syncthreads();
    LAS float* PS = (LAS float*)F.lds;
#pragma unroll
    for (int t = 0; t < 5; ++t)
#pragma unroll
        for (int j = 0; j < 4; ++j) PS[(w * 16 + fq * 4 + j) * NRC + t * 16 + fr] = acc[t][j];
    LDS_WAIT(); __syncthreads();
    if (F.tid < 16) { const int lr = F.tid, r = row0 + lr;
        float gl_[8]; float mx = -3.0e38f; int gi = 0;
#pragma unroll
        for (int c = 0; c < 8; ++c) { float s = 0.f;
#pragma unroll
            for (int ww = 0; ww < 8; ++ww) s += PS[(ww * 16 + lr) * NRC + c];
            gl_[c] = s + rbg[c]; if (gl_[c] > mx) { mx = gl_[c]; gi = c; } }
        float den = 0.f;
#pragma unroll
        for (int c = 0; c < 8; ++c) den += expf(gl_[c] - mx);
        const float pg = 1.0f / den;
        float v0 = -3.0e38f, v1 = -3.0e38f; int i0 = 0, i1 = 0;
#pragma unroll
        for (int e = 0; e < 8; ++e) { float s = 0.f;
#pragma unroll
            for (int ww = 0; ww < 8; ++ww) s += PS[(ww * 16 + lr) * NRC + 8 + gi * 8 + e];
            const float le = s + rbe[gi * 8 + e];
            if (le > v0) { v1 = v0; i1 = i0; v0 = le; i0 = e; } else if (le > v1) { v1 = le; i1 = e; } }
        const float ex = expf(v1 - v0), w0 = pg / (1.0f + ex), w1 = pg * ex / (1.0f + ex);
        const int e0 = gi * 8 + i0, e1 = gi * 8 + i1;
        const unsigned p0 = __hip_atomic_fetch_add((unsigned*)(F.ctl + CW_CNT + 64 * e0), 1u, RLX_AGENT);
        const unsigned p1 = __hip_atomic_fetch_add((unsigned*)(F.ctl + CW_CNT + 64 * e1), 1u, RLX_AGENT);
        ltok[(size_t)e0 * LISTCAP + p0] = r; lwt[(size_t)e0 * LISTCAP + p0] = w0;
        ltok[(size_t)e1 * LISTCAP + p1] = r; lwt[(size_t)e1 * LISTCAP + p1] = w1;
        *(int4*)(rout + (size_t)r * 4) = make_int4(e0, e1, (int)p0, (int)p1);
    }
    LDS_WAIT(); __syncthreads();
}

__device__ __forceinline__ void build_tables(Frame& F) {
    LAS int* tstart = (LAS int*)(F.lds + TAB_OFF); LAS int* texp = tstart + 80;
    __syncthreads();
    if (F.tid < 64) {
        const unsigned c = __hip_atomic_load((unsigned*)(F.ctl + CW_CNT + 64 * F.tid), RLX_AGENT);
        int tl = (int)((c + 255u) >> 8), incl = tl;
#pragma unroll
        for (int o = 1; o < 64; o <<= 1) { const int t = __shfl_up(incl, o); if (F.lane >= o) incl += t; }
        tstart[F.tid + 1] = incl; if (F.tid == 0) tstart[0] = 0;
    }
    LDS_WAIT(); __syncthreads();
    for (int mt = F.tid; mt < MT_MAX; mt += NWAVES * 64) { int e = 0;
        for (int j = 1; j < NE; ++j) e += (tstart[j] <= mt) ? 1 : 0;
        texp[mt] = e; }
    LDS_WAIT(); __syncthreads();
}

constexpr int N_PHASES = 9;
__global__ void __launch_bounds__(NWAVES * 64, 2) hybrid_fwd(Args args) {
    extern __shared__ __attribute__((aligned(16))) unsigned char lds[];
    Frame F;
    F.lds = (LAS unsigned char*)lds;
    F.MISC = (volatile LAS unsigned*)(F.lds + MISC_OFF);
    F.tid = threadIdx.x; F.lane = F.tid & 63; F.wave = __builtin_amdgcn_readfirstlane(F.tid >> 6);
    F.G = gridDim.x; { const int bx = blockIdx.x; F.vcu = (F.G % 8 == 0) ? (bx % 8) * (F.G / 8) + bx / 8 : bx; }
    unsigned char* ws = args.ws;
    F.ctl = (gu32*)(ws + WS_CTL);
    const float* x = args.in[0]; const float* cvec = args.in[1]; const float* ada_w = args.in[2]; const float* ada_b = args.in[3]; const float* norm1_g = args.in[4];
    const float* w_in = args.in[5]; const float* conv3_w = args.in[6]; const float* conv4_w = args.in[7]; const float* conv4_b = args.in[8];
    const float* lru_w_a = args.in[9]; const float* lru_b_a = args.in[10]; const float* lru_w_x = args.in[11]; const float* lru_b_x = args.in[12]; const float* lru_lambda = args.in[13];
    const float* hn_conv_g = args.in[14]; const float* hn_lru_g = args.in[15]; const float* w_out = args.in[16]; const float* norm2_g = args.in[17];
    const float* rwg = args.in[18]; const float* rbg = args.in[19]; const float* rwe = args.in[20]; const float* rbe = args.in[21];
    const float* w_e_gate = args.in[22]; const float* w_e_up = args.in[23]; const float* w_e_down = args.in[24]; const float* final_g = args.in[25];
    float* out = args.out;
    float* mod = (float*)(ws + WS_MOD); int* rout = (int*)(ws + WS_ROUT);
    bf16* wr_hi = (bf16*)(ws + WS_WR); bf16* wr_lo = wr_hi + NRC * D;
    int* ltok = (int*)(ws + WS_LTOK); float* lwt = (float*)(ws + WS_LW);
    bf16* Win_t = (bf16*)(ws + WS_WIN); bf16* Wout_t = (bf16*)(ws + WS_WOUT); bf16* Wgu_t = (bf16*)(ws + WS_WGU); bf16* Wd_t = (bf16*)(ws + WS_WD);
    bf16* XN = (bf16*)(ws + WS_XN); bf16* PROJ = (bf16*)(ws + WS_PROJ); bf16* YE = (bf16*)(ws + WS_PROJ); bf16* Y = (bf16*)(ws + WS_Y); bf16* HB = (bf16*)(ws + WS_Y);

    for (int u = F.tid; u < (LDS_BYTES - LDSCTL_OFF) / 4; u += NWAVES * 64) ((LAS unsigned*)(F.lds + LDSCTL_OFF))[u] = 0u;
    __syncthreads();
    XcdBarrier bar; bar.bar = (unsigned*)(F.ctl + CW_BAR); bar.x = 0; bar.st = nullptr;
    if (MK_N_LAUNCHES == 1) bar = xcd_barrier_post((unsigned*)(F.ctl + CW_BAR), F.MISC + 8);
    const int lo = args.ph_lo, hi = args.ph_hi;
#ifndef PHASE_MASK
#define PHASE_MASK 0x1ff
#endif
#define IN(k) (((PHASE_MASK >> (k)) & 1) && lo <= (k) && (k) < hi)
#define SEAM(k) do { if (IN(k) && IN((k) + 1)) xcd_barrier(bar); } while (0)
    const int gw = F.vcu * NWAVES + F.wave, NGW = F.G * NWAVES;

    if (IN(0)) {
        for (int u = blockIdx.x; u < (6 * D) / 64; u += F.G) p0_mod_unit(F, cvec, ada_w, ada_b, mod, u);
        for (int idx = blockIdx.x * (NWAVES * 64) + F.tid; idx < NRC * D; idx += F.G * NWAVES * 64) { const int n = idx / D, k = idx % D;
            const float v = n < 8 ? rwg[k * 8 + n] : (n < 72 ? rwe[(size_t)((n - 8) >> 3) * D * 8 + k * 8 + ((n - 8) & 7)] : 0.f);
            const unsigned h = cvtpk(v, 0.f) & 0xffffu; wr_hi[idx] = (bf16)h; wr_lo[idx] = (bf16)(cvtpk(v - bf_lo(h), 0.f) & 0xffffu); }
        LAS float* scr = (LAS float*)(F.lds + F.wave * 16640);
        constexpr int I_IN = (D / 64) * (DIN / 64), I_OUT = (D / 64) * (D / 64), I_GU = NE * (D / 64) * (DE / 64), I_DN = NE * (DE / 64) * (D / 64);
        constexpr int NITEMS = I_IN + I_OUT + 2 * I_GU + I_DN;
        for (int it = gw; it < NITEMS; it += NGW) {
            int r = it;
            if (r < I_IN) { const int nb = r % (DIN / 64), kb = r / (DIN / 64); p0_transpose_item(w_in, DIN, kb * 64, nb * 64, Win_t, (size_t)nb * 64, D, scr, F.lane); continue; } r -= I_IN;
            if (r < I_OUT) { const int nb = r % (D / 64), kb = r / (D / 64); p0_transpose_item(w_out, D, kb * 64, nb * 64, Wout_t, (size_t)nb * 64, D, scr, F.lane); continue; } r -= I_OUT;
            if (r < 2 * I_GU) { const int up = r >= I_GU ? 1 : 0; r -= up * I_GU; const int e = r / ((D / 64) * (DE / 64)), rr = r % ((D / 64) * (DE / 64)), nb = rr % (DE / 64), kb = rr / (DE / 64), n0 = nb * 64;
                p0_transpose_item((up ? w_e_up : w_e_gate) + (size_t)e * D * DE, DE, kb * 64, n0, Wgu_t, (size_t)e * 1024 + (n0 >> 7) * 256 + up * 128 + (n0 & 127), D, scr, F.lane); continue; } r -= 2 * I_GU;
            { const int e = r / ((DE / 64) * (D / 64)), rr = r % ((DE / 64) * (D / 64)), nb = rr % (D / 64), kb = rr / (D / 64);
                p0_transpose_item(w_e_down + (size_t)e * DE * D, D, kb * 64, nb * 64, Wd_t, (size_t)e * D + nb * 64, DE, scr, F.lane); }
        }
    }
    SEAM(0);
    if (IN(1)) {
        for (int grp = gw; grp < M / 16; grp += NGW) { const int r0 = grp * 16, b = r0 / SEQ; const float* mb = mod + (size_t)b * (6 * D);
            modnorm_rows(F, x, XN, norm1_g, mb, mb + D, r0, 16); }
    }
    SEAM(1);
    if (IN(2)) {
        pg8::Gemm g{XN, Win_t, D}; pg8::StaticOrder S; S.init(M, DIN, F.G, (int)blockIdx.x);
        pg8::EpiBf16 E{PROJ, DIN};
        pg8::gemm_phase<pg8::EpiBf16, pg8::StaticOrder, true>(F.lds, g, S, E);
    }
    SEAM(2);
    if (IN(3)) {
        for (int u = blockIdx.x; u < 256; u += F.G) {
#ifndef NO_MIXB
            if (u < 128) mixer_b_unit(F, PROJ, Y, conv4_w, conv4_b, lru_w_a, lru_b_a, lru_w_x, lru_b_x, lru_lambda, hn_lru_g, u);
#endif
#ifndef NO_MIXA
            if (u >= 128) mixer_a_unit(F, PROJ, Y, conv3_w, hn_conv_g, u - 128);
#endif
        }
    }
    SEAM(3);
    if (IN(4)) {
        pg8::Gemm g{Y, Wout_t, D}; pg8::StaticOrder S; S.init(M, D, F.G, (int)blockIdx.x);
        pg8::EpiRes E{x, out, mod + 2 * D};
        pg8::gemm_phase<pg8::EpiRes, pg8::StaticOrder, true>(F.lds, g, S, E);
    }
    SEAM(4);
    if (IN(5)) {
        for (int grp = blockIdx.x; grp < M / 128; grp += F.G) { const int b = (grp * 128) / SEQ; const float* mb = mod + (size_t)b * (6 * D);
            f32x4 mu[8], ad[8];
#pragma unroll
            for (int j = 0; j < 8; ++j) { const f32x4 g = ((const f32x4*)norm2_g)[F.lane + 64 * j], sc = ((const f32x4*)(mb + 4 * D))[F.lane + 64 * j]; mu[j] = g * (1.0f + sc); ad[j] = ((const f32x4*)(mb + 3 * D))[F.lane + 64 * j]; }
#pragma unroll 1
            for (int p = 0; p < 8; ++p) p5_pass(F, out, XN, mu, ad, wr_hi, wr_lo, rbg, rbe, grp * 128 + p * 16, rout, ltok, lwt);
        }
    }
    SEAM(5);
    if (IN(6)) {
        build_tables(F);
        pg8::Gemm g{XN, Wgu_t, D};
        pg8::GroupedOrder<4, true> S{(const LAS int*)(F.lds + TAB_OFF), (const LAS int*)(F.lds + TAB_OFF) + 80, ltok, (const unsigned*)(F.ctl + CW_CNT), F.G, F.vcu};
        pg8::EpiSwiGLU E{HB};
        pg8::gemm_phase<pg8::EpiSwiGLU, pg8::GroupedOrder<4, true>, true>(F.lds, g, S, E);
    }
    SEAM(6);
    if (IN(7)) {
        build_tables(F);
        pg8::Gemm g{HB, Wd_t, DE};
        pg8::GroupedOrder<8, false> S{(const LAS int*)(F.lds + TAB_OFF), (const LAS int*)(F.lds + TAB_OFF) + 80, ltok, (const unsigned*)(F.ctl + CW_CNT), F.G, F.vcu};
        pg8::EpiScale E{YE, lwt};
        pg8::gemm_phase<pg8::EpiScale, pg8::GroupedOrder<8, false>, true>(F.lds, g, S, E);
    }
    SEAM(7);
    if (IN(8)) {
        build_tables(F);
        const LAS int* tstart = (const LAS int*)(F.lds + TAB_OFF);
        for (int grp = gw; grp < M / 16; grp += NGW) { const int r0 = grp * 16, b = r0 / SEQ; const float* g2 = mod + (size_t)b * (6 * D) + 5 * D;
            f32x4 gg[8], fg[8];
#pragma unroll
            for (int j = 0; j < 8; ++j) { gg[j] = ((const f32x4*)g2)[F.lane + 64 * j]; fg[j] = ((const f32x4*)final_g)[F.lane + 64 * j]; }
            for (int r = r0; r < r0 + 16; ++r) {
                const int4 ro = *(const int4*)(rout + (size_t)r * 4);
                const size_t s0 = (size_t)tstart[ro.x] * 256 + ro.z, s1 = (size_t)tstart[ro.y] * 256 + ro.w;
                const v2u* y0 = (const v2u*)(YE + s0 * D) + F.lane; const v2u* y1 = (const v2u*)(YE + s1 * D) + F.lane;
                f32x4* xr = (f32x4*)(out + (size_t)r * D) + F.lane;
                f32x4 v[8]; float s = 0.f;
#pragma unroll
                for (int j = 0; j < 8; ++j) { const v2u a = y0[64 * j], c = y1[64 * j]; const f32x4 xv = xr[64 * j];
                    const f32x4 ys = {bf_lo(a.x) + bf_lo(c.x), bf_hi(a.x) + bf_hi(c.x), bf_lo(a.y) + bf_lo(c.y), bf_hi(a.y) + bf_hi(c.y)};
                    v[j] = xv + gg[j] * ys; s += (v[j].x * v[j].x + v[j].y * v[j].y) + (v[j].z * v[j].z + v[j].w * v[j].w); }
                const float rstd = 1.0f / sqrtf(wave_sum(s) * (1.0f / D) + EPS);
#pragma unroll
                for (int j = 0; j < 8; ++j) xr[64 * j] = v[j] * rstd * fg[j];
            }
        }
    }
#undef IN
#undef SEAM
}

extern "C" void kernel_launch(void* const* d_in, const int* in_sizes, int n_in, void* d_out, int out_size, void* d_ws, size_t ws_size, hipStream_t stream) {
    static int grid = 0;
    if (grid == 0) {
        if (n_in != 26 || in_sizes[0] != M * D || out_size != M * D || ws_size < WS_END) { fprintf(stderr, "kernel_launch: unexpected shapes (n_in %d, in0 %d, out %d, ws %zu < %zu); nothing launched\n", n_in, n_in > 0 ? in_sizes[0] : -1, out_size, ws_size, (size_t)WS_END); grid = -1; return; }
        int dev = 0, cus = 0, per_cu = 0;
        if (hipGetDevice(&dev) != hipSuccess || hipDeviceGetAttribute(&cus, hipDeviceAttributeMultiprocessorCount, dev) != hipSuccess) { fprintf(stderr, "kernel_launch: device query failed\n"); grid = -1; return; }
        if (hipFuncSetAttribute((const void*)hybrid_fwd, hipFuncAttributeMaxDynamicSharedMemorySize, LDS_BYTES) != hipSuccess) { fprintf(stderr, "kernel_launch: hipFuncSetAttribute failed\n"); grid = -1; return; }
        if (hipOccupancyMaxActiveBlocksPerMultiprocessor(&per_cu, (const void*)hybrid_fwd, NWAVES * 64, LDS_BYTES) != hipSuccess || per_cu < 1) { fprintf(stderr, "kernel_launch: occupancy query reports %d workgroups per CU\n", per_cu); }
        (void)hipGetLastError();
        grid = cus;
        if (grid % 8 != 0 || grid < 8) { fprintf(stderr, "kernel_launch: grid %d not a multiple of 8\n", grid); grid = -1; return; }
    }
    if (grid < 0) return;
    if (hipMemsetAsync((char*)d_ws + WS_CTL, 0, CTL_ZERO_BYTES, stream) != hipSuccess) { fprintf(stderr, "kernel_launch: memset failed\n"); return; }
    Args a{};
    for (int i = 0; i < 26; ++i) a.in[i] = (const float*)d_in[i];
    a.out = (float*)d_out; a.ws = (unsigned char*)d_ws;
    for (int li = 0; li < MK_N_LAUNCHES; ++li) {
        a.ph_lo = (MK_N_LAUNCHES == 1) ? 0 : li; a.ph_hi = (MK_N_LAUNCHES == 1) ? N_PHASES : li + 1;
        hipLaunchKernelGGL(hybrid_fwd, dim3(grid), dim3(NWAVES * 64), LDS_BYTES, stream, a);
        const hipError_t le = hipPeekAtLastError();
        if (le != hipSuccess) { fprintf(stderr, "kernel_launch: launch %d failed: %s\n", li, hipGetErrorName(le)); break; }
    }
}
```

```cpp
#include <hip/hip_runtime.h>
#include <cstdio>
#include <cstdint>

#ifndef MK_N_LAUNCHES
#define MK_N_LAUNCHES 1
#endif

constexpr int D = 2048, NB = 16, SEQ = 2048, M = NB * SEQ;
constexpr int DC = 1024, DL = 1024, DIN = 5120;
constexpr int CONV_HD = 64, LRU_HEADS = 8, LRU_HD = 128;
constexpr int NE = 64, NGRP = 8, EPG = 8, DE = 512;
constexpr int NRC = 80;
constexpr float EPS = 1e-6f;
constexpr int MT_MAX = (2 * M) / 256 + NE;
constexpr int LISTCAP = M;

constexpr size_t MiB = 1u << 20;
constexpr size_t WS_CTL = 0, CTL_ZERO_BYTES = 1 * MiB;
constexpr size_t WS_MOD = 1 * MiB;
constexpr size_t WS_ROUT = 2 * MiB;
constexpr size_t WS_WR = 3 * MiB;
constexpr size_t WS_LTOK = 4 * MiB;
constexpr size_t WS_LW = 12 * MiB;
constexpr size_t WS_WIN = 20 * MiB;
constexpr size_t WS_WOUT = 40 * MiB;
constexpr size_t WS_WGU = 48 * MiB;
constexpr size_t WS_WD = 304 * MiB;
constexpr size_t WS_XN = 432 * MiB;
constexpr size_t WS_PROJ = 560 * MiB;
constexpr size_t WS_Y = 880 * MiB;
constexpr size_t WS_MIX = 1008 * MiB;
constexpr size_t WS_END = 1136 * MiB;
constexpr int CW_BAR = 4096;
constexpr int CW_CNT = 16384;

constexpr int RING_BYTES = 131072;
constexpr int LDSCTL_OFF = 143360;
constexpr int LDS_BYTES = 147456;
constexpr int MISC_OFF = LDSCTL_OFF;
constexpr int TAB_OFF = LDSCTL_OFF + 256;
constexpr int NWAVES = 8;

#define GAS __attribute__((address_space(1)))
#define LAS __attribute__((address_space(3)))
typedef unsigned short bf16;
typedef unsigned v4u __attribute__((ext_vector_type(4)));
typedef unsigned v2u __attribute__((ext_vector_type(2)));
typedef float f32x4 __attribute__((ext_vector_type(4)));
typedef float f32x2 __attribute__((ext_vector_type(2)));
typedef float f32x16 __attribute__((ext_vector_type(16)));
typedef short bf16x8 __attribute__((ext_vector_type(8)));
typedef __bf16 bf16x2_t __attribute__((ext_vector_type(2)));
typedef GAS unsigned gu32;
#define RLX_AGENT __ATOMIC_RELAXED, __HIP_MEMORY_SCOPE_AGENT
#define LDS_WAIT() asm volatile("s_waitcnt lgkmcnt(0)" ::: "memory")
#define VM_WAIT() asm volatile("s_waitcnt vmcnt(0)" ::: "memory")

__device__ __forceinline__ unsigned cvtpk(float lo, float hi) { f32x2 v = {lo, hi}; bf16x2_t b = __builtin_convertvector(v, bf16x2_t); return __builtin_bit_cast(unsigned, b); }
__device__ __forceinline__ float bf_lo(unsigned w) { return __builtin_bit_cast(float, w << 16); }
__device__ __forceinline__ float bf_hi(unsigned w) { return __builtin_bit_cast(float, w & 0xffff0000u); }
__device__ __forceinline__ float bf2f(bf16 b) { return __builtin_bit_cast(float, ((unsigned)b) << 16); }
__device__ __forceinline__ float fast_rcp(float x) { return __builtin_amdgcn_rcpf(x); }
__device__ __forceinline__ float fast_exp(float x) { return __builtin_amdgcn_exp2f(x * 1.44269504089f); }
__device__ __forceinline__ float fast_sqrt(float x) { return __builtin_amdgcn_sqrtf(x); }
__device__ __forceinline__ float fast_rsq(float x) { return __builtin_amdgcn_rsqf(x); }
__device__ __forceinline__ float sigmoidf_(float x) { return fast_rcp(1.0f + fast_exp(-x)); }
__device__ __forceinline__ float wave_sum(float v) {
#pragma unroll
    for (int o = 1; o < 64; o <<= 1) v += __shfl_xor(v, o);
    return v;
}

namespace pg8 {
constexpr int BM = 256, BK = 64, HALF = 128, HTB = HALF * BK * 2, STAGE_BYTES = 8 * HTB, NXCD = 8, WGM = 8;
__host__ __device__ __forceinline__ int lds_byte(int r, int c) { const int st = (r >> 4) * 2 + (c >> 5), rr = r & 15, cc = c & 31, ob = rr * 64 + cc * 2; return st * 1024 + (ob ^ (((ob >> 9) & 1) << 5)); }
__host__ __device__ __forceinline__ void stage_rc(int b, int& R, int& C) { const int st = b / 1024, sb = b % 1024, swz = sb ^ (((sb >> 9) & 1) << 5); R = (st >> 1) * 16 + swz / 64; C = (st & 1) * 32 + (swz % 64) / 2; }
__host__ __device__ __forceinline__ int perm32(int rho) { const int n = rho >> 4, i = rho & 15; return 8 * (i >> 2) + 4 * n + (i & 3); }

struct Unit { int pm, pn, e, r0, cnt, nt; };
struct Gemm { const bf16* A; const bf16* Bt; int K; };

struct StaticOrder {
    int nM, nN, nwg, G, c;
    __device__ void init(int M_, int N_, int G_, int c_) { nM = M_ / BM; nN = N_ / BM; nwg = nM * nN; G = G_; c = c_; }
    __device__ __forceinline__ bool next(int i, Unit& u) const {
        const long L = (long)i * G + c; if (L >= nwg) return false;
        int wgid = (int)L; { const int q = nwg / NXCD, r = nwg % NXCD, xcd = wgid % NXCD, off = wgid / NXCD; wgid = (xcd < r ? xcd * (q + 1) : r * (q + 1) + (xcd - r) * q) + off; }
        const int nig = WGM * nN, gid = wgid / nig, fm = gid * WGM, gsz = (nM - fm) < WGM ? (nM - fm) : WGM;
        u.pm = fm + ((wgid % nig) % gsz); u.pn = (wgid % nig) / gsz; u.e = 0; u.r0 = 0; u.cnt = 0; u.nt = 0; return true;
    }
    __device__ __forceinline__ void a_off(const Unit&, const int (&R)[2], const int (&C)[2], int K, unsigned (&o)[2][2]) const {
#pragma unroll
        for (int h = 0; h < 2; ++h)
#pragma unroll
            for (int i = 0; i < 2; ++i) o[h][i] = (unsigned)((h * HALF + R[i]) * K + C[i]) * 2u;
    }
    __device__ __forceinline__ const char* a_base(const Gemm& g, const Unit& u) const { return (const char*)g.A + (size_t)u.pm * ((size_t)BM * g.K * 2); }
};
template <int NT, bool GATHER> struct GroupedOrder {
    const LAS int* tstart; const LAS int* texp; const int* ltok; const unsigned* cnt; int G, vcu;
    __device__ __forceinline__ bool next(int i, Unit& u) const {
        const int total = __builtin_amdgcn_readfirstlane(tstart[NE]) * NT;
        const int gx = G >> 3, x = vcu / gx, j = vcu % gx;
        const int per = (total + 7) >> 3, q = x * per + j + i * gx;
        if (j + i * gx >= per || q >= total) return false;
        const int mt = q / NT; u.nt = q % NT; u.pm = mt;
        const int e = __builtin_amdgcn_readfirstlane(texp[mt]); u.e = e; u.pn = e * NT + u.nt;
        u.r0 = (mt - __builtin_amdgcn_readfirstlane(tstart[e])) * BM;
        u.cnt = __builtin_amdgcn_readfirstlane(tstart[80 + MT_MAX + e]);
        return true;
    }
    __device__ __forceinline__ void a_off(const Unit& u, const int (&R)[2], const int (&C)[2], int K, unsigned (&o)[2][2]) const {
#pragma unroll
        for (int h = 0; h < 2; ++h)
#pragma unroll
            for (int i = 0; i < 2; ++i) {
                if (GATHER) { const int rie = u.r0 + h * HALF + R[i]; const int tok = rie < u.cnt ? ltok[(size_t)u.e * LISTCAP + rie] : 0; o[h][i] = (unsigned)(tok * K + C[i]) * 2u; }
                else o[h][i] = (unsigned)((h * HALF + R[i]) * K + C[i]) * 2u;
            }
    }
    __device__ __forceinline__ const char* a_base(const Gemm& g, const Unit& u) const { return GATHER ? (const char*)g.A : (const char*)g.A + (size_t)u.pm * ((size_t)BM * g.K * 2); }
};

struct EpiBf16 {
    static constexpr bool PERM = true;
    bf16* O; int ldc;
    __device__ __forceinline__ void operator()(const f32x4 (&acc)[2][2][4][2], const Unit& u, int wr, int wc, int fr, int fq) const {
        const int row0 = u.pm * BM + wr * 64 + fr, col0 = u.pn * BM + wc * 32 + 8 * fq;
#pragma unroll
        for (int ai = 0; ai < 2; ++ai)
#pragma unroll
            for (int m = 0; m < 4; ++m) { bf16* rowp = O + (size_t)(row0 + ai * HALF + m * 16) * ldc + col0;
#pragma unroll
                for (int bj = 0; bj < 2; ++bj) { const f32x4 v0 = acc[ai][bj][m][0], v1 = acc[ai][bj][m][1];
                    v4u w; w.x = cvtpk(v0[0], v0[1]); w.y = cvtpk(v0[2], v0[3]); w.z = cvtpk(v1[0], v1[1]); w.w = cvtpk(v1[2], v1[3]);
                    *(v4u*)(rowp + bj * HALF) = w; } }
    }
};
struct EpiRes {
    static constexpr bool PERM = false;
    const float* x; float* out; const float* gate;
    __device__ __forceinline__ void operator()(const f32x4 (&acc)[2][2][4][2], const Unit& u, int wr, int wc, int fr, int fq) const {
        const int row0 = u.pm * BM + wr * 64 + fr, col0 = u.pn * BM + wc * 32 + 4 * fq;
        const float* gp = gate + (size_t)((u.pm * BM) / SEQ) * (6 * D) + col0;
        f32x4 gv[2][2];
#pragma unroll
        for (int bj = 0; bj < 2; ++bj)
#pragma unroll
            for (int n = 0; n < 2; ++n) gv[bj][n] = *(const f32x4*)(gp + bj * HALF + n * 16);
#pragma unroll
        for (int ai = 0; ai < 2; ++ai)
#pragma unroll
            for (int m = 0; m < 4; ++m) { const size_t off = (size_t)(row0 + ai * HALF + m * 16) * D + col0;
#pragma unroll
                for (int bj = 0; bj < 2; ++bj)
#pragma unroll
                    for (int n = 0; n < 2; ++n) { const f32x4 xs = *(const f32x4*)(x + off + bj * HALF + n * 16);
                        *(f32x4*)(out + off + bj * HALF + n * 16) = xs + gv[bj][n] * acc[ai][bj][m][n]; }
                asm volatile("" ::: "memory"); }
    }
};
struct EpiSwiGLU {
    static constexpr bool PERM = true;
    bf16* H;
    __device__ __forceinline__ void operator()(const f32x4 (&acc)[2][2][4][2], const Unit& u, int wr, int wc, int fr, int fq) const {
        const int row0 = u.pm * BM + wr * 64 + fr, col0 = u.nt * HALF + wc * 32 + 8 * fq;
#pragma unroll
        for (int ai = 0; ai < 2; ++ai)
#pragma unroll
            for (int m = 0; m < 4; ++m) { bf16* rowp = H + (size_t)(row0 + ai * HALF + m * 16) * DE + col0;
                float h[8];
#pragma unroll
                for (int n = 0; n < 2; ++n)
#pragma unroll
                    for (int j = 0; j < 4; ++j) { const float g = acc[ai][0][m][n][j], up = acc[ai][1][m][n][j]; h[n * 4 + j] = g * sigmoidf_(g) * up; }
                v4u w; w.x = cvtpk(h[0], h[1]); w.y = cvtpk(h[2], h[3]); w.z = cvtpk(h[4], h[5]); w.w = cvtpk(h[6], h[7]);
                *(v4u*)rowp = w; }
    }
};
struct EpiScale {
    static constexpr bool PERM = true;
    bf16* O; const float* lw;
    __device__ __forceinline__ void operator()(const f32x4 (&acc)[2][2][4][2], const Unit& u, int wr, int wc, int fr, int fq) const {
        const int rt0 = wr * 64 + fr, col0 = u.nt * BM + wc * 32 + 8 * fq;
        float wv[2][4];
#pragma unroll
        for (int ai = 0; ai < 2; ++ai)
#pragma unroll
            for (int m = 0; m < 4; ++m) { const int rie = u.r0 + rt0 + ai * HALF + m * 16; wv[ai][m] = rie < u.cnt ? lw[(size_t)u.e * LISTCAP + rie] : 0.f; }
#pragma unroll
        for (int ai = 0; ai < 2; ++ai)
#pragma unroll
            for (int m = 0; m < 4; ++m) { bf16* rowp = O + (size_t)(u.pm * BM + rt0 + ai * HALF + m * 16) * D + col0; const float s = wv[ai][m];
#pragma unroll
                for (int bj = 0; bj < 2; ++bj) { const f32x4 v0 = acc[ai][bj][m][0] * s, v1 = acc[ai][bj][m][1] * s;
                    v4u w; w.x = cvtpk(v0[0], v0[1]); w.y = cvtpk(v0[2], v0[3]); w.z = cvtpk(v1[0], v1[1]); w.w = cvtpk(v1[2], v1[3]);
                    *(v4u*)(rowp + bj * HALF) = w; } }
    }
};

template <class Epi, class Sched, bool ALIGN_EPI>
__device__ __forceinline__ void gemm_phase(LAS unsigned char* lds, const Gemm g, const Sched& S, const Epi& E) {
    const int tid = threadIdx.x, wid = __builtin_amdgcn_readfirstlane(tid >> 6), lane = tid & 63, wr = wid >> 2, wc = wid & 3, fr = lane & 15, fq = lane >> 4;
    const int K = g.K, nt = K / BK;
    int Rr[2], Cc[2]; unsigned voffB[2];
#pragma unroll
    for (int i = 0; i < 2; ++i) { int R, C; stage_rc(tid * 16 + i * 8192, R, C); const int Rb = Epi::PERM ? ((R & ~31) + perm32(R & 31)) : R; Rr[i] = R; Cc[i] = C; voffB[i] = (unsigned)(Rb * K + C) * 2u; }
    const size_t kstep = (size_t)(BK * 2);
    const size_t hstep = (size_t)HALF * K * 2;
    const size_t tstep = 2 * hstep;
    const unsigned ldsw = (unsigned)wid * 1024u;
    const int aoff = lds_byte(wr * 64 + fr, fq * 8), boff = lds_byte(wc * 32 + fr, fq * 8);
#define PG8_SA(b, h) (((b) * 2 + (h)) * HTB)
#define PG8_SB(b, h) ((4 + (b) * 2 + (h)) * HTB)
#define PG8_STAGE(bufoff, gbase, voff) do { _Pragma("unroll") for (int _i = 0; _i < 2; ++_i) \
        __builtin_amdgcn_global_load_lds((const unsigned*)((const char*)(gbase) + (voff)[_i]), (LAS unsigned*)(lds + (bufoff) + ldsw + _i * 8192), 16, 0, 0); } while (0)
#define PG8_LDA(dst, b, h) do { _Pragma("unroll") for (int m = 0; m < 4; ++m) _Pragma("unroll") for (int k = 0; k < 2; ++k) dst[m][k] = *(const LAS bf16x8*)(lds + PG8_SA(b, h) + aoff + m * 2048 + k * 1024); } while (0)
#define PG8_LDB(dst, b, h) do { _Pragma("unroll") for (int n = 0; n < 2; ++n) _Pragma("unroll") for (int k = 0; k < 2; ++k) dst[n][k] = *(const LAS bf16x8*)(lds + PG8_SB(b, h) + boff + n * 2048 + k * 1024); } while (0)
#define PG8_MMA(ai, bj, At, Bt) do { __builtin_amdgcn_s_setprio(1); _Pragma("unroll") for (int m = 0; m < 4; ++m) _Pragma("unroll") for (int n = 0; n < 2; ++n) _Pragma("unroll") for (int k = 0; k < 2; ++k) \
        acc[ai][bj][m][n] = __builtin_amdgcn_mfma_f32_16x16x32_bf16(Bt[n][k], At[m][k], acc[ai][bj][m][n], 0, 0, 0); __builtin_amdgcn_s_setprio(0); } while (0)
#define PG8_WAIT_V(n) asm volatile("s_waitcnt vmcnt(" #n ")" ::: "memory")
#define PG8_WAIT_L(n) asm volatile("s_waitcnt lgkmcnt(" #n ")" ::: "memory")
#define PG8_BAR __builtin_amdgcn_s_barrier()
#define PG8_SCHED __builtin_amdgcn_sched_barrier(0)
    Unit cur, nxt; int ui = 0;
    if (!S.next(0, cur)) return;
    f32x4 acc[2][2][4][2];
#pragma unroll
    for (int a = 0; a < 2; ++a)
#pragma unroll
        for (int b = 0; b < 2; ++b)
#pragma unroll
            for (int m = 0; m < 4; ++m)
#pragma unroll
                for (int n = 0; n < 2; ++n) acc[a][b][m][n] = (f32x4){0.f, 0.f, 0.f, 0.f};
    bf16x8 At[4][2], B0[2][2], B1[2][2];
    unsigned cO[2][2], nO[2][2];
    S.a_off(cur, Rr, Cc, K, cO);
    const char* cA = S.a_base(g, cur); const char* cB = (const char*)g.Bt + (size_t)cur.pn * tstep;
    PG8_STAGE(PG8_SB(0, 0), cB, voffB); PG8_STAGE(PG8_SB(0, 1), cB + hstep, voffB); PG8_STAGE(PG8_SA(0, 0), cA, cO[0]); PG8_STAGE(PG8_SA(0, 1), cA, cO[1]);
    if (wr == 1) PG8_BAR;
    PG8_WAIT_V(2); PG8_BAR;
    PG8_STAGE(PG8_SB(1, 0), cB + kstep, voffB); PG8_STAGE(PG8_SA(1, 0), cA + kstep, cO[0]); PG8_STAGE(PG8_SB(1, 1), cB + hstep + kstep, voffB);
    PG8_WAIT_V(6); PG8_BAR;
    for (;;) {
        const bool has_next = S.next(ui + 1, nxt);
        const char* nA = cA; const char* nB = cB;
#pragma unroll
        for (int h = 0; h < 2; ++h)
#pragma unroll
            for (int i = 0; i < 2; ++i) nO[h][i] = cO[h][i];
        if (has_next) { S.a_off(nxt, Rr, Cc, K, nO); nA = S.a_base(g, nxt); nB = (const char*)g.Bt + (size_t)nxt.pn * tstep; }
        for (int t = 0; t < nt; t += 2) {
            const bool last = (t == nt - 2);
            const char* a1 = cA + (size_t)(t + 1) * kstep;
            const char* a2 = last ? nA : cA + (size_t)(t + 2) * kstep; const char* b2 = last ? nB : cB + (size_t)(t + 2) * kstep;
            const char* a3 = a2 + kstep; const char* b3 = b2 + kstep;
            unsigned o2[2][2];
#pragma unroll
            for (int h = 0; h < 2; ++h)
#pragma unroll
                for (int i = 0; i < 2; ++i) o2[h][i] = last ? nO[h][i] : cO[h][i];
            PG8_LDB(B0, 0, 0); PG8_LDB(B1, 0, 1); PG8_SCHED; PG8_LDA(At, 0, 0); PG8_STAGE(PG8_SA(1, 1), a1, cO[1]);
            PG8_WAIT_V(8); PG8_WAIT_L(0); PG8_BAR; PG8_MMA(0, 0, At, B0); PG8_MMA(0, 1, At, B1); PG8_BAR; PG8_SCHED;
            PG8_LDA(At, 0, 1); PG8_STAGE(PG8_SB(0, 0), b2, voffB); PG8_STAGE(PG8_SB(0, 1), b2 + hstep, voffB); PG8_STAGE(PG8_SA(0, 0), a2, o2[0]);
            PG8_WAIT_V(8); PG8_WAIT_L(0); PG8_BAR; PG8_MMA(1, 0, At, B0); PG8_MMA(1, 1, At, B1); PG8_BAR; PG8_SCHED;
            PG8_LDB(B0, 1, 0); PG8_LDB(B1, 1, 1); PG8_SCHED; PG8_LDA(At, 1, 0); PG8_STAGE(PG8_SA(0, 1), a2, o2[1]);
            PG8_WAIT_V(8); PG8_WAIT_L(0); PG8_BAR; PG8_MMA(0, 0, At, B0); PG8_MMA(0, 1, At, B1); PG8_BAR; PG8_SCHED;
            PG8_LDA(At, 1, 1); PG8_STAGE(PG8_SB(1, 0), b3, voffB); PG8_STAGE(PG8_SB(1, 1), b3 + hstep, voffB); PG8_STAGE(PG8_SA(1, 0), a3, o2[0]);
            PG8_WAIT_V(8); PG8_WAIT_L(0); PG8_BAR; PG8_MMA(1, 0, At, B0); PG8_MMA(1, 1, At, B1); PG8_BAR; PG8_SCHED;
        }
        if constexpr (ALIGN_EPI) { if (wr == 0) PG8_BAR; }
        E(acc, cur, wr, wc, fr, fq);
        if (!has_next) break;
#pragma unroll
        for (int a = 0; a < 2; ++a)
#pragma unroll
            for (int b = 0; b < 2; ++b)
#pragma unroll
                for (int m = 0; m < 4; ++m)
#pragma unroll
                    for (int n = 0; n < 2; ++n) acc[a][b][m][n] = (f32x4){0.f, 0.f, 0.f, 0.f};
        cur = nxt; cA = nA; cB = nB; ++ui;
#pragma unroll
        for (int h = 0; h < 2; ++h)
#pragma unroll
            for (int i = 0; i < 2; ++i) cO[h][i] = nO[h][i];
        if constexpr (ALIGN_EPI) { if (wr == 1) PG8_BAR; }
    }
    PG8_WAIT_V(0);
    if constexpr (!ALIGN_EPI) { if (wr == 0) PG8_BAR; }
    PG8_BAR;
#undef PG8_SA
#undef PG8_SB
#undef PG8_STAGE
#undef PG8_LDA
#undef PG8_LDB
#undef PG8_MMA
#undef PG8_WAIT_V
#undef PG8_WAIT_L
#undef PG8_BAR
#undef PG8_SCHED
}
}

#define XB_TMO      128
#define XB_XCNT(j)  (256  + 64 * (j))
#define XB_XSUB(j)  (1280 + 64 * (j))
#define XB_XGEN(j)  (2304 + 64 * (j))
#define XB_TOP      3328
#define XB_TOPGEN   3392
#define XCD_BAR_WORDS 3456
#define XB_SPIN_CAP (1u << 18)
__device__ __forceinline__ unsigned xb_ld(unsigned* p)              { return __hip_atomic_load(p, __ATOMIC_RELAXED, __HIP_MEMORY_SCOPE_AGENT); }
__device__ __forceinline__ unsigned xb_add(unsigned* p, unsigned v) { return __hip_atomic_fetch_add(p, v, __ATOMIC_RELAXED, __HIP_MEMORY_SCOPE_AGENT); }
__device__ __forceinline__ unsigned xb_xcc_id() { return (unsigned)__builtin_amdgcn_s_getreg((3 << 11) | 20) & 0xFu; }
#define XB_SPIN(cond, bar) do { unsigned _sp = 0; while (cond) { __builtin_amdgcn_s_sleep(1); \
    if ((++_sp & 255u) == 0u) { if (xb_ld(&(bar)[XB_TMO])) break; if (_sp > XB_SPIN_CAP) { atomicAdd(&(bar)[XB_TMO], 1u); break; } } } } while (0)
struct XcdBarrier { unsigned* bar; unsigned x; volatile LAS unsigned* st; };
__device__ __forceinline__ XcdBarrier xcd_barrier_post(unsigned* bar, volatile LAS unsigned* st) {
    XcdBarrier b; b.bar = bar; b.x = xb_xcc_id(); b.st = st;
    if (threadIdx.x == 0) (void)xb_add(&bar[XB_XCNT(b.x)], 1u);
    return b;
}
__device__ __forceinline__ void xcd_barrier_complete(unsigned* bar, unsigned x, unsigned& nloc, unsigned& nx) {
    const unsigned G = gridDim.x * gridDim.y * gridDim.z;
    unsigned sum, cnt, mine, sp = 0u;
    for (;;) {
        sum = 0u; cnt = 0u; mine = 0u;
#pragma unroll
        for (unsigned j = 0; j < 16; ++j) { const unsigned c = xb_ld(&bar[XB_XCNT(j)]); sum += c; cnt += (c > 0u) ? 1u : 0u; mine = (j == x) ? c : mine; }
        if (sum == G) break;
        __builtin_amdgcn_s_sleep(1);
        if ((++sp & 255u) == 0u) { if (xb_ld(&bar[XB_TMO])) break; if (sp > XB_SPIN_CAP) { atomicAdd(&bar[XB_TMO], 1u); break; } }
    }
    nloc = mine > 0u ? mine : 1u; nx = cnt > 0u ? cnt : 1u;
}
__device__ __forceinline__ void xcd_barrier(const XcdBarrier& b) {
    asm volatile("s_waitcnt vmcnt(0)" ::: "memory");
    __syncthreads();
    if (threadIdx.x == 0) {
        unsigned* bar = b.bar;
        __builtin_amdgcn_s_waitcnt(0);
        unsigned nloc = b.st[0], nx = b.st[1];
        if (nloc == 0u) { xcd_barrier_complete(bar, b.x, nloc, nx); b.st[0] = nloc; b.st[1] = nx; }
        const unsigned old = xb_add(&bar[XB_XSUB(b.x)], 1u);
        const unsigned gen = old / nloc;
        if (old + 1u == (gen + 1u) * nloc) {
            __builtin_amdgcn_fence(__ATOMIC_RELEASE, "agent");
            asm volatile("s_waitcnt vmcnt(0)" ::: "memory");
            const unsigned og = xb_add(&bar[XB_TOP], 1u);
            const unsigned tg = og / nx;
            if (og + 1u == (tg + 1u) * nx) xb_add(&bar[XB_TOPGEN], 1u);
            else XB_SPIN(xb_ld(&bar[XB_TOPGEN]) == tg, bar);
            __builtin_amdgcn_fence(__ATOMIC_ACQUIRE, "agent");
            xb_add(&bar[XB_XGEN(b.x)], 1u);
            asm volatile("s_waitcnt vmcnt(0)" ::: "memory");
        } else {
            XB_SPIN(xb_ld(&bar[XB_XGEN(b.x)]) == gen, bar);
            __builtin_amdgcn_fence(__ATOMIC_ACQUIRE, "agent");
            asm volatile("s_waitcnt vmcnt(0)" ::: "memory");
        }
    }
    __syncthreads();
}

struct Frame {
    LAS unsigned char* lds;
    volatile LAS unsigned* MISC;
    gu32* ctl;
    int tid, lane, wave, vcu, G;
};
struct Args {
    const float* in[26]; float* out; unsigned char* ws; int ph_lo, ph_hi;
};

__device__ __forceinline__ void p0_transpose_item(const float* W, int N, int k0, int n0, bf16* WT, size_t drow0, int Kd, LAS float* scr, int lane) {
    const int lq = lane & 15, lk = lane >> 4;
#pragma unroll 8
    for (int i = 0; i < 16; ++i) { const int kk = 4 * i + lk; const f32x4 v = *(const f32x4*)(W + (size_t)(k0 + kk) * N + n0 + 4 * lq);
        LAS float* s = scr + kk * 65 + 4 * lq; s[0] = v.x; s[1] = v.y; s[2] = v.z; s[3] = v.w; }
    LDS_WAIT(); asm volatile("" ::: "memory");
    const int c = lane & 7;
#pragma unroll
    for (int j = 0; j < 8; ++j) { const int n = (lane >> 3) + 8 * j; const LAS float* s = scr + (8 * c) * 65 + n;
        v4u o; o.x = cvtpk(s[0 * 65], s[1 * 65]); o.y = cvtpk(s[2 * 65], s[3 * 65]); o.z = cvtpk(s[4 * 65], s[5 * 65]); o.w = cvtpk(s[6 * 65], s[7 * 65]);
        *(v4u*)(WT + (drow0 + n) * (size_t)Kd + k0 + 8 * c) = o; }
    LDS_WAIT(); asm volatile("" ::: "memory");
}
__device__ __forceinline__ void p0_mod_unit(Frame& F, const float* c, const float* ada_w, const float* ada_b, float* mod, int unit) {
    const int n0 = unit * 64, lane = F.lane, w = F.wave, k0 = w * 256;
    LAS float* sc = (LAS float*)(F.lds + w * 16384);
    for (int b = 0; b < NB; ++b)
#pragma unroll
        for (int j = 0; j < 4; ++j) { const float v = c[(size_t)b * D + k0 + 64 * j + lane]; sc[(64 * j + lane) * 16 + b] = v * sigmoidf_(v); }
    LDS_WAIT(); asm volatile("" ::: "memory");
    float acc[NB][4];
#pragma unroll
    for (int b = 0; b < NB; ++b)
#pragma unroll
        for (int j = 0; j < 4; ++j) acc[b][j] = 0.f;
    const int lq = lane & 15, lk = lane >> 4;
#pragma unroll 4
    for (int i = 0; i < 64; ++i) { const int kk = 4 * i + lk; const f32x4 wv = *(const f32x4*)(ada_w + (size_t)(k0 + kk) * (6 * D) + n0 + 4 * lq);
        const LAS f32x4* sp = (const LAS f32x4*)(sc + kk * 16);
#pragma unroll
        for (int q = 0; q < 4; ++q) { const f32x4 s4 = sp[q];
#pragma unroll
            for (int bb = 0; bb < 4; ++bb)
#pragma unroll
                for (int j = 0; j < 4; ++j) acc[q * 4 + bb][j] += s4[bb] * wv[j]; } }
    LDS_WAIT(); asm volatile("" ::: "memory");
    LAS f32x4* rp = (LAS f32x4*)(F.lds + w * 16384) + lane * 16;
#pragma unroll
    for (int b = 0; b < NB; ++b) rp[b] = (f32x4){acc[b][0], acc[b][1], acc[b][2], acc[b][3]};
    LDS_WAIT(); __syncthreads();
    for (int o = F.tid; o < NB * 64; o += NWAVES * 64) { const int b = o >> 6, n = o & 63, q = n >> 2, j = n & 3; float s = 0.f;
#pragma unroll
        for (int ww = 0; ww < 8; ++ww)
#pragma unroll
            for (int gq = 0; gq < 4; ++gq) s += ((const LAS float*)(F.lds + ww * 16384))[(gq * 16 + q) * 64 + b * 4 + j];
        mod[(size_t)b * (6 * D) + n0 + n] = s + ada_b[n0 + n]; }
    LDS_WAIT(); __syncthreads();
}

__device__ __forceinline__ void modnorm_rows(Frame& F, const float* xin, bf16* xn, const float* gain, const float* shift, const float* scale, int r0, int nrows) {
    f32x4 mu[8], ad[8];
#pragma unroll
    for (int j = 0; j < 8; ++j) { const f32x4 g = ((const f32x4*)gain)[F.lane + 64 * j], sc = ((const f32x4*)scale)[F.lane + 64 * j]; mu[j] = g * (1.0f + sc); ad[j] = ((const f32x4*)shift)[F.lane + 64 * j]; }
    for (int r = r0; r < r0 + nrows; ++r) {
        const f32x4* xr = (const f32x4*)(xin + (size_t)r * D) + F.lane;
        f32x4 v[8]; float s = 0.f;
#pragma unroll
        for (int j = 0; j < 8; ++j) { v[j] = xr[64 * j]; s += (v[j].x * v[j].x + v[j].y * v[j].y) + (v[j].z * v[j].z + v[j].w * v[j].w); }
        const float rstd = 1.0f / sqrtf(wave_sum(s) * (1.0f / D) + EPS);
        v2u* o8 = (v2u*)(xn + (size_t)r * D) + F.lane;
#pragma unroll
        for (int j = 0; j < 8; ++j) { const f32x4 h = v[j] * rstd * mu[j] + ad[j]; v2u w; w.x = cvtpk(h.x, h.y); w.y = cvtpk(h.z, h.w); o8[64 * j] = w; }
    }
}

__device__ __forceinline__ float gelu_tanh(float x) {
    const float t = 1.5957691216f * (x + 0.044715f * x * x * x);
    return x * sigmoidf_(t);
}
__device__ __forceinline__ void mixer_a_unit(Frame& F, const bf16* proj, bf16* Y, const float* conv3_w, const float* gconv, int ua) {
    const int ch0 = (F.wave & 1) * 512 + F.lane * 8, t0 = ua * 256 + (F.wave >> 1) * 64;
    float w0[8], w1[8], w2[8], gg[8];
#pragma unroll
    for (int j = 0; j < 8; ++j) { w0[j] = conv3_w[ch0 + j]; w1[j] = conv3_w[DC + ch0 + j]; w2[j] = conv3_w[2 * DC + ch0 + j]; gg[j] = gconv[ch0 + j]; }
    float u1[8], u2[8];
    const bool hist = (t0 % SEQ) != 0;
    {
        v4u c1 = {0, 0, 0, 0}, x1 = {0, 0, 0, 0}, c2 = {0, 0, 0, 0}, x2 = {0, 0, 0, 0};
        if (hist) { const bf16* p1 = proj + (size_t)(t0 - 1) * DIN + ch0; const bf16* p2 = proj + (size_t)(t0 - 2) * DIN + ch0;
            c1 = *(const v4u*)(p1 + DC); x1 = *(const v4u*)(p1 + 2 * DC); c2 = *(const v4u*)(p2 + DC); x2 = *(const v4u*)(p2 + 2 * DC); }
#pragma unroll
        for (int q = 0; q < 4; ++q) { u1[2 * q] = bf_lo(c1[q]) * bf_lo(x1[q]); u1[2 * q + 1] = bf_hi(c1[q]) * bf_hi(x1[q]); u2[2 * q] = bf_lo(c2[q]) * bf_lo(x2[q]); u2[2 * q + 1] = bf_hi(c2[q]) * bf_hi(x2[q]); }
    }
#pragma unroll 4
    for (int t = t0; t < t0 + 64; ++t) {
        const bf16* p = proj + (size_t)t * DIN + ch0;
        const v4u bv = *(const v4u*)p, cv = *(const v4u*)(p + DC), xv = *(const v4u*)(p + 2 * DC);
        float y[8]; float ss = 0.f;
#pragma unroll
        for (int q = 0; q < 4; ++q) {
            const float ua0 = bf_lo(cv[q]) * bf_lo(xv[q]), ub0 = bf_hi(cv[q]) * bf_hi(xv[q]);
            const float va = w0[2 * q] * u2[2 * q] + w1[2 * q] * u1[2 * q] + w2[2 * q] * ua0;
            const float vb = w0[2 * q + 1] * u2[2 * q + 1] + w1[2 * q + 1] * u1[2 * q + 1] + w2[2 * q + 1] * ub0;
            u2[2 * q] = u1[2 * q]; u1[2 * q] = ua0; u2[2 * q + 1] = u1[2 * q + 1]; u1[2 * q + 1] = ub0;
            y[2 * q] = bf_lo(bv[q]) * va; y[2 * q + 1] = bf_hi(bv[q]) * vb;
            ss += y[2 * q] * y[2 * q] + y[2 * q + 1] * y[2 * q + 1];
        }
        ss += __shfl_xor(ss, 1); ss += __shfl_xor(ss, 2); ss += __shfl_xor(ss, 4);
        const float rstd = fast_rsq(ss * (1.0f / CONV_HD) + EPS);
        v4u o;
#pragma unroll
        for (int q = 0; q < 4; ++q) o[q] = cvtpk(y[2 * q] * rstd * gg[2 * q], y[2 * q + 1] * rstd * gg[2 * q + 1]);
        *(v4u*)(Y + (size_t)t * D + ch0) = o;
    }
}
constexpr int MB_TB = 128, MB_PITCH = 272;
constexpr int MB_XI = 0, MB_ST = MB_TB * MB_PITCH, MB_SS = 2 * MB_TB * MB_PITCH, MB_C4 = MB_SS + 8 * MB_TB * 4, MB_END = MB_C4 + 5 * 128 * 4;
static_assert(MB_END <= LDSCTL_OFF, "mixer B LDS");
__device__ __forceinline__ void mixer_b_unit(Frame& F, const bf16* proj, bf16* Y, const float* conv4_w, const float* conv4_b, const float* lru_w_a, const float* lru_b_a,
                                             const float* lru_w_x, const float* lru_b_x, const float* lam, const float* glru, int unit) {
    const int b = unit >> 3, hd = unit & 7, lane = F.lane, w = F.wave, c = lane & 15, kg = lane >> 4;
    LAS float* C4 = (LAS float*)(F.lds + MB_C4);
    __syncthreads();
    for (int idx = F.tid; idx < 5 * 128; idx += NWAVES * 64) { const int tap = idx >> 7, ch = idx & 127; C4[idx] = tap < 4 ? conv4_w[tap * DL + hd * 128 + ch] : conv4_b[hd * 128 + ch]; }
    bf16x8 fa[4], fx[4];
#pragma unroll
    for (int ks = 0; ks < 4; ++ks) { float ta[8], tx[8];
#pragma unroll
        for (int j = 0; j < 8; ++j) { const size_t o = (size_t)hd * 16384 + (size_t)(32 * ks + 8 * kg + j) * 128 + 16 * w + c; ta[j] = lru_w_a[o]; tx[j] = lru_w_x[o]; }
        v4u pa, px; pa.x = cvtpk(ta[0], ta[1]); pa.y = cvtpk(ta[2], ta[3]); pa.z = cvtpk(ta[4], ta[5]); pa.w = cvtpk(ta[6], ta[7]);
        px.x = cvtpk(tx[0], tx[1]); px.y = cvtpk(tx[2], tx[3]); px.z = cvtpk(tx[4], tx[5]); px.w = cvtpk(tx[6], tx[7]);
        fa[ks] = __builtin_bit_cast(bf16x8, pa); fx[ks] = __builtin_bit_cast(bf16x8, px); }
    bf16x8 idn;
#pragma unroll
    for (int j = 0; j < 8; ++j) idn[j] = (8 * kg + j == 16 * (w & 1) + c) ? (short)0x3f80 : (short)0;
    const int ch = hd * 128 + 16 * w + c;
    const float ba = lru_b_a[ch], bx = lru_b_x[ch], nsp = -8.0f * log1pf(expf(-lam[ch]));
    const int pc = F.tid & 15, tg = F.tid >> 4;
    float gl8[8];
#pragma unroll
    for (int j = 0; j < 8; ++j) gl8[j] = glru[hd * 128 + pc * 8 + j];
    LAS unsigned char* xi_w = F.lds + MB_XI + (4 * tg) * MB_PITCH + pc * 16;
    LAS unsigned char* xi_r = F.lds + MB_XI + c * MB_PITCH + kg * 16;
    LAS unsigned char* st_w = F.lds + MB_ST + (4 * kg) * MB_PITCH + (16 * w + c) * 2;
    LAS float* ss_w = (LAS float*)(F.lds + MB_SS) + w * MB_TB + 4 * kg;
    LAS unsigned char* c4l = F.lds + MB_C4 + pc * 32;
    asm volatile("" : "+v"(xi_w), "+v"(xi_r), "+v"(st_w), "+v"(ss_w), "+v"(c4l));
    const bf16* xb = proj + (size_t)b * SEQ * DIN + 4 * 1024 + hd * 128 + pc * 8;
    const bf16* gb = proj + (size_t)b * SEQ * DIN + 3 * 1024 + hd * 128 + 32 * (w >> 1) + 8 * kg;
    bf16* yo = Y + (size_t)b * SEQ * D + DC + hd * 128 + pc * 8;
    float hc = 0.f;
    LDS_WAIT(); __syncthreads();
#pragma unroll 1
    for (int tb = 0; tb < SEQ / MB_TB; ++tb) {
        const int t0 = tb * MB_TB;
        {
            float wt[4][8], bs[8];
#pragma unroll
            for (int tap = 0; tap < 4; ++tap) { const LAS f32x4* wp = (const LAS f32x4*)(c4l + tap * 512); const f32x4 wa = wp[0], wb = wp[1];
                wt[tap][0] = wa.x; wt[tap][1] = wa.y; wt[tap][2] = wa.z; wt[tap][3] = wa.w; wt[tap][4] = wb.x; wt[tap][5] = wb.y; wt[tap][6] = wb.z; wt[tap][7] = wb.w; }
            { const LAS f32x4* wp = (const LAS f32x4*)(c4l + 4 * 512); const f32x4 wa = wp[0], wb = wp[1]; bs[0] = wa.x; bs[1] = wa.y; bs[2] = wa.z; bs[3] = wa.w; bs[4] = wb.x; bs[5] = wb.y; bs[6] = wb.z; bs[7] = wb.w; }
            v4u rows[7];
#pragma unroll
            for (int i = 0; i < 7; ++i) { const int tt = t0 + 4 * tg - 3 + i; rows[i] = (v4u){0, 0, 0, 0}; if (tt >= 0) rows[i] = *(const v4u*)(xb + (size_t)tt * DIN); }
#pragma unroll
            for (int i = 0; i < 4; ++i) { float xc[8];
#pragma unroll
                for (int j = 0; j < 8; ++j) xc[j] = bs[j];
#pragma unroll
                for (int tap = 0; tap < 4; ++tap) { const v4u v = rows[i + tap];
                    xc[0] += wt[tap][0] * bf_lo(v.x); xc[1] += wt[tap][1] * bf_hi(v.x); xc[2] += wt[tap][2] * bf_lo(v.y); xc[3] += wt[tap][3] * bf_hi(v.y);
                    xc[4] += wt[tap][4] * bf_lo(v.z); xc[5] += wt[tap][5] * bf_hi(v.z); xc[6] += wt[tap][6] * bf_lo(v.w); xc[7] += wt[tap][7] * bf_hi(v.w); }
                v4u p; p.x = cvtpk(xc[0], xc[1]); p.y = cvtpk(xc[2], xc[3]); p.z = cvtpk(xc[4], xc[5]); p.w = cvtpk(xc[6], xc[7]);
                *(LAS v4u*)(xi_w + i * MB_PITCH) = p; }
        }
        LDS_WAIT(); __syncthreads();
#pragma unroll 1
        for (int s = 0; s < MB_TB / 16; ++s) {
            const bf16x8 gfr = *(const bf16x8*)(gb + (size_t)(t0 + 16 * s + c) * DIN);
            f32x4 ar = {0.f, 0.f, 0.f, 0.f}, ai = ar, ax = ar, ag = ar;
            const LAS unsigned char* xr = xi_r + s * (16 * MB_PITCH);
#pragma unroll
            for (int ks = 0; ks < 4; ++ks) { const bf16x8 af = *(const LAS bf16x8*)(xr + ks * 64);
                ar = __builtin_amdgcn_mfma_f32_16x16x32_bf16(af, fa[ks], ar, 0, 0, 0);
                ai = __builtin_amdgcn_mfma_f32_16x16x32_bf16(af, fx[ks], ai, 0, 0, 0); }
            { const bf16x8 af = *(const LAS bf16x8*)(xr + (w >> 1) * 64); ax = __builtin_amdgcn_mfma_f32_16x16x32_bf16(af, idn, ax, 0, 0, 0); }
            ag = __builtin_amdgcn_mfma_f32_16x16x32_bf16(gfr, idn, ag, 0, 0, 0);
            float Hl[4], Pl[4]; float h = 0.f, P = 1.f;
#pragma unroll
            for (int v = 0; v < 4; ++v) {
                const float r = sigmoidf_(ar[v] + ba), ig = sigmoidf_(ai[v] + bx);
                const float la = nsp * r, a = fast_exp(la), z = 2.0f * la;
                const float em1 = z * (1.0f + z * (0.5f + z * (0.16666667f + z * (0.041666668f + z * 0.0083333333f))));
                const float om = (z > -0.35f) ? -em1 : 1.0f - fast_exp(z);
                const float u = fast_sqrt(om) * ig * ax[v];
                h = a * h + u; P *= a; Hl[v] = h; Pl[v] = P; }
            float X = hc, Xn = hc;
#pragma unroll
            for (int g = 0; g < 4; ++g) { const float pg = __shfl(P, c + 16 * g), hg = __shfl(h, c + 16 * g); if (g == kg) X = Xn; Xn = pg * Xn + hg; }
            hc = Xn;
            float yb[4]; f32x4 ss;
#pragma unroll
            for (int v = 0; v < 4; ++v) { const float hv = Pl[v] * X + Hl[v]; yb[v] = hv * gelu_tanh(ag[v]); ss[v] = yb[v] * yb[v]; }
#pragma unroll
            for (int o = 1; o < 16; o <<= 1) { ss[0] += __shfl_xor(ss[0], o); ss[1] += __shfl_xor(ss[1], o); ss[2] += __shfl_xor(ss[2], o); ss[3] += __shfl_xor(ss[3], o); }
            if (c == 0) *(LAS f32x4*)(ss_w + 16 * s) = ss;
#pragma unroll
            for (int v = 0; v < 4; ++v) *(LAS bf16*)(st_w + (16 * s + v) * MB_PITCH) = (bf16)(cvtpk(yb[v], 0.f) & 0xffffu);
        }
        LDS_WAIT(); __syncthreads();
#pragma unroll
        for (int i = 0; i < 4; ++i) { const int tk = 4 * tg + i; float sq = 0.f;
#pragma unroll
            for (int ww = 0; ww < 8; ++ww) sq += ((const LAS float*)(F.lds + MB_SS))[ww * MB_TB + tk];
            const float rstd = fast_rsq(sq * (1.0f / LRU_HD) + EPS);
            const v4u p = *(const LAS v4u*)(xi_w + (MB_ST - MB_XI) + i * MB_PITCH);
            v4u o; o.x = cvtpk(bf_lo(p.x) * rstd * gl8[0], bf_hi(p.x) * rstd * gl8[1]); o.y = cvtpk(bf_lo(p.y) * rstd * gl8[2], bf_hi(p.y) * rstd * gl8[3]);
            o.z = cvtpk(bf_lo(p.z) * rstd * gl8[4], bf_hi(p.z) * rstd * gl8[5]); o.w = cvtpk(bf_lo(p.w) * rstd * gl8[6], bf_hi(p.w) * rstd * gl8[7]);
            *(v4u*)(yo + (size_t)(t0 + tk) * D) = o; }
    }
    __syncthreads();
}

constexpr int P5_ROWB = 4112;
constexpr int P5_HI = 0, P5_LO = 16 * P5_ROWB, P5_END = 2 * 16 * P5_ROWB;
static_assert(P5_END <= LDSCTL_OFF && 8 * 16 * NRC * 4 <= P5_END, "P5 LDS");
__device__ __forceinline__ void p5_pass(Frame& F, const float* x, const bf16* mix, const float* g1, bf16* xn, const f32x4 (&mu)[8], const f32x4 (&ad)[8], const bf16* wr_hi, const bf16* wr_lo,
                                        const float* rbg, const float* rbe, int row0, int* rout, int* ltok, float* lwt) {
    const int lane = F.lane, w = F.wave;
#pragma unroll 1
    for (int rr = 0; rr < 2; ++rr) { const int lr = 2 * w + rr, r = row0 + lr;
        const f32x4* xr = (const f32x4*)(x + (size_t)r * D) + lane; const v2u* mr = (const v2u*)(mix + (size_t)r * D) + lane;
        f32x4 v[8]; float s = 0.f;
#pragma unroll
        for (int j = 0; j < 8; ++j) { const v2u mv = mr[64 * j]; const f32x4 gv = ((const f32x4*)g1)[lane + 64 * j];
            v[j] = xr[64 * j] + gv * (f32x4){bf_lo(mv.x), bf_hi(mv.x), bf_lo(mv.y), bf_hi(mv.y)}; s += (v[j].x * v[j].x + v[j].y * v[j].y) + (v[j].z * v[j].z + v[j].w * v[j].w); }
        const float rstd = fast_rsq(wave_sum(s) * (1.0f / D) + EPS);
        v2u* o8 = (v2u*)(xn + (size_t)r * D) + lane;
#pragma unroll
        for (int j = 0; j < 8; ++j) { const f32x4 h = v[j] * rstd * mu[j] + ad[j]; v2u hi; hi.x = cvtpk(h.x, h.y); hi.y = cvtpk(h.z, h.w); o8[64 * j] = hi;
            v2u lo; lo.x = cvtpk(h.x - bf_lo(hi.x), h.y - bf_hi(hi.x)); lo.y = cvtpk(h.z - bf_lo(hi.y), h.w - bf_hi(hi.y));
            *(LAS v2u*)(F.lds + P5_HI + lr * P5_ROWB + (lane + 64 * j) * 8) = hi; *(LAS v2u*)(F.lds + P5_LO + lr * P5_ROWB + (lane + 64 * j) * 8) = lo; }
    }
    LDS_WAIT(); __syncthreads();
    const int fr = lane & 15, fq = lane >> 4;
    f32x4 acc[5];
#pragma unroll
    for (int t = 0; t < 5; ++t) acc[t] = (f32x4){0.f, 0.f, 0.f, 0.f};
#pragma unroll 1
    for (int ks = 0; ks < 8; ++ks) { const int k = w * 256 + ks * 32 + 8 * fq;
        const bf16x8 ah = *(const LAS bf16x8*)(F.lds + P5_HI + fr * P5_ROWB + k * 2), al = *(const LAS bf16x8*)(F.lds + P5_LO + fr * P5_ROWB + k * 2);
#pragma unroll
        for (int t = 0; t < 5; ++t) { const bf16x8 bh = *(const bf16x8*)(wr_hi + (size_t)(t * 16 + fr) * D + k), bl = *(const bf16x8*)(wr_lo + (size_t)(t * 16 + fr) * D + k);
            acc[t] = __builtin_amdgcn_mfma_f32_16x16x32_bf16(ah, bh, acc[t], 0, 0, 0);
            acc[t] = __builtin_amdgcn_mfma_f32_16x16x32_bf16(ah, bl, acc[t], 0, 0, 0);
            acc[t] = __builtin_amdgcn_mfma_f32_16x16x32_bf16(al, bh, acc[t], 0, 0, 0); } }
    LDS_WAIT(); __syncthreads();
    LAS float* PS = (LAS float*)F.lds;
#pragma unroll
    for (int t = 0; t < 5; ++t)
#pragma unroll
        for (int j = 0; j < 4; ++j) PS[(w * 16 + fq * 4 + j) * NRC + t * 16 + fr] = acc[t][j];
    LDS_WAIT(); __syncthreads();
    if (F.tid < 16) { const int lr = F.tid, r = row0 + lr;
        float gl_[8]; float mx = -3.0e38f; int gi = 0;
#pragma unroll
        for (int c = 0; c < 8; ++c) { float s = 0.f;
#pragma unroll
            for (int ww = 0; ww < 8; ++ww) s += PS[(ww * 16 + lr) * NRC + c];
            gl_[c] = s + rbg[c]; if (gl_[c] > mx) { mx = gl_[c]; gi = c; } }
        float den = 0.f;
#pragma unroll
        for (int c = 0; c < 8; ++c) den += expf(gl_[c] - mx);
        const float pg = 1.0f / den;
        float v0 = -3.0e38f, v1 = -3.0e38f; int i0 = 0, i1 = 0;
#pragma unroll
        for (int e = 0; e < 8; ++e) { float s = 0.f;
#pragma unroll
            for (int ww = 0; ww < 8; ++ww) s += PS[(ww * 16 + lr) * NRC + 8 + gi * 8 + e];
            const float le = s + rbe[gi * 8 + e];
            if (le > v0) { v1 = v0; i1 = i0; v0 = le; i0 = e; } else if (le > v1) { v1 = le; i1 = e; } }
        const float ex = expf(v1 - v0), w0 = pg / (1.0f + ex), w1 = pg * ex / (1.0f + ex);
        const int e0 = gi * 8 + i0, e1 = gi * 8 + i1;
        const unsigned p0 = __hip_atomic_fetch_add((unsigned*)(F.ctl + CW_CNT + 64 * e0), 1u, RLX_AGENT);
        const unsigned p1 = __hip_atomic_fetch_add((unsigned*)(F.ctl + CW_CNT + 64 * e1), 1u, RLX_AGENT);
        ltok[(size_t)e0 * LISTCAP + p0] = r; lwt[(size_t)e0 * LISTCAP + p0] = w0;
        ltok[(size_t)e1 * LISTCAP + p1] = r; lwt[(size_t)e1 * LISTCAP + p1] = w1;
        *(int4*)(rout + (size_t)r * 4) = make_int4(e0, e1, (int)p0, (int)p1);
    }
    LDS_WAIT(); __syncthreads();
}

__device__ __forceinline__ void build_tables(Frame& F) {
    LAS int* tstart = (LAS int*)(F.lds + TAB_OFF); LAS int* texp = tstart + 80;
    __syncthreads();
    if (F.tid < 64) {
        const unsigned c = __hip_atomic_load((unsigned*)(F.ctl + CW_CNT + 64 * F.tid), RLX_AGENT);
        int tl = (int)((c + 255u) >> 8), incl = tl;
#pragma unroll
        for (int o = 1; o < 64; o <<= 1) { const int t = __shfl_up(incl, o); if (F.lane >= o) incl += t; }
        tstart[F.tid + 1] = incl; if (F.tid == 0) tstart[0] = 0; tstart[80 + MT_MAX + F.tid] = (int)c;
    }
    LDS_WAIT(); __syncthreads();
    for (int mt = F.tid; mt < MT_MAX; mt += NWAVES * 64) { int e = 0;
        for (int j = 1; j < NE; ++j) e += (tstart[j] <= mt) ? 1 : 0;
        texp[mt] = e; }
    LDS_WAIT(); __syncthreads();
}

constexpr int N_PHASES = 9;
__global__ void __launch_bounds__(NWAVES * 64, 2) hybrid_fwd(Args args) {
    extern __shared__ __attribute__((aligned(16))) unsigned char lds[];
    Frame F;
    F.lds = (LAS unsigned char*)lds;
    F.MISC = (volatile LAS unsigned*)(F.lds + MISC_OFF);
    F.tid = threadIdx.x; F.lane = F.tid & 63; F.wave = __builtin_amdgcn_readfirstlane(F.tid >> 6);
    F.G = gridDim.x; { const int bx = blockIdx.x; F.vcu = (F.G % 8 == 0) ? (bx % 8) * (F.G / 8) + bx / 8 : bx; }
    unsigned char* ws = args.ws;
    F.ctl = (gu32*)(ws + WS_CTL);
    const float* x = args.in[0]; const float* cvec = args.in[1]; const float* ada_w = args.in[2]; const float* ada_b = args.in[3]; const float* norm1_g = args.in[4];
    const float* w_in = args.in[5]; const float* conv3_w = args.in[6]; const float* conv4_w = args.in[7]; const float* conv4_b = args.in[8];
    const float* lru_w_a = args.in[9]; const float* lru_b_a = args.in[10]; const float* lru_w_x = args.in[11]; const float* lru_b_x = args.in[12]; const float* lru_lambda = args.in[13];
    const float* hn_conv_g = args.in[14]; const float* hn_lru_g = args.in[15]; const float* w_out = args.in[16]; const float* norm2_g = args.in[17];
    const float* rwg = args.in[18]; const float* rbg = args.in[19]; const float* rwe = args.in[20]; const float* rbe = args.in[21];
    const float* w_e_gate = args.in[22]; const float* w_e_up = args.in[23]; const float* w_e_down = args.in[24]; const float* final_g = args.in[25];
    float* out = args.out;
    float* mod = (float*)(ws + WS_MOD); int* rout = (int*)(ws + WS_ROUT);
    bf16* wr_hi = (bf16*)(ws + WS_WR); bf16* wr_lo = wr_hi + NRC * D;
    int* ltok = (int*)(ws + WS_LTOK); float* lwt = (float*)(ws + WS_LW);
    bf16* Win_t = (bf16*)(ws + WS_WIN); bf16* Wout_t = (bf16*)(ws + WS_WOUT); bf16* Wgu_t = (bf16*)(ws + WS_WGU); bf16* Wd_t = (bf16*)(ws + WS_WD);
    bf16* XN = (bf16*)(ws + WS_XN); bf16* PROJ = (bf16*)(ws + WS_PROJ); bf16* YE = (bf16*)(ws + WS_PROJ); bf16* Y = (bf16*)(ws + WS_Y); bf16* HB = (bf16*)(ws + WS_Y); bf16* MIX = (bf16*)(ws + WS_MIX);

    for (int u = F.tid; u < (LDS_BYTES - LDSCTL_OFF) / 4; u += NWAVES * 64) ((LAS unsigned*)(F.lds + LDSCTL_OFF))[u] = 0u;
    __syncthreads();
    XcdBarrier bar; bar.bar = (unsigned*)(F.ctl + CW_BAR); bar.x = 0; bar.st = nullptr;
    if (MK_N_LAUNCHES == 1) bar = xcd_barrier_post((unsigned*)(F.ctl + CW_BAR), F.MISC + 8);
    const int lo = args.ph_lo, hi = args.ph_hi;
#ifndef PHASE_MASK
#define PHASE_MASK 0x1ff
#endif
#define IN(k) (((PHASE_MASK >> (k)) & 1) && lo <= (k) && (k) < hi)
#define SEAM(k) do { if (IN(k) && IN((k) + 1)) xcd_barrier(bar); } while (0)
    const int gw = F.vcu * NWAVES + F.wave, NGW = F.G * NWAVES;

    if (IN(0)) {
        for (int u = blockIdx.x; u < (6 * D) / 64; u += F.G) p0_mod_unit(F, cvec, ada_w, ada_b, mod, u);
        for (int idx = blockIdx.x * (NWAVES * 64) + F.tid; idx < NRC * D; idx += F.G * NWAVES * 64) { const int n = idx / D, k = idx % D;
            const float v = n < 8 ? rwg[k * 8 + n] : (n < 72 ? rwe[(size_t)((n - 8) >> 3) * D * 8 + k * 8 + ((n - 8) & 7)] : 0.f);
            const unsigned h = cvtpk(v, 0.f) & 0xffffu; wr_hi[idx] = (bf16)h; wr_lo[idx] = (bf16)(cvtpk(v - bf_lo(h), 0.f) & 0xffffu); }
        LAS float* scr = (LAS float*)(F.lds + F.wave * 16640);
        constexpr int I_IN = (D / 64) * (DIN / 64), I_OUT = (D / 64) * (D / 64), I_GU = NE * (D / 64) * (DE / 64), I_DN = NE * (DE / 64) * (D / 64);
        constexpr int NITEMS = I_IN + I_OUT + 2 * I_GU + I_DN;
        for (int it = gw; it < NITEMS; it += NGW) {
            int r = it;
            if (r < I_IN) { const int nb = r % (DIN / 64), kb = r / (DIN / 64); p0_transpose_item(w_in, DIN, kb * 64, nb * 64, Win_t, (size_t)nb * 64, D, scr, F.lane); continue; } r -= I_IN;
            if (r < I_OUT) { const int nb = r % (D / 64), kb = r / (D / 64); p0_transpose_item(w_out, D, kb * 64, nb * 64, Wout_t, (size_t)nb * 64, D, scr, F.lane); continue; } r -= I_OUT;
            if (r < 2 * I_GU) { const int up = r >= I_GU ? 1 : 0; r -= up * I_GU; const int e = r / ((D / 64) * (DE / 64)), rr = r % ((D / 64) * (DE / 64)), nb = rr % (DE / 64), kb = rr / (DE / 64), n0 = nb * 64;
                p0_transpose_item((up ? w_e_up : w_e_gate) + (size_t)e * D * DE, DE, kb * 64, n0, Wgu_t, (size_t)e * 1024 + (n0 >> 7) * 256 + up * 128 + (n0 & 127), D, scr, F.lane); continue; } r -= 2 * I_GU;
            { const int e = r / ((DE / 64) * (D / 64)), rr = r % ((DE / 64) * (D / 64)), nb = rr % (D / 64), kb = rr / (D / 64);
                p0_transpose_item(w_e_down + (size_t)e * DE * D, D, kb * 64, nb * 64, Wd_t, (size_t)e * D + nb * 64, DE, scr, F.lane); }
        }
    }
    SEAM(0);
    if (IN(1)) {
        for (int grp = gw; grp < M / 16; grp += NGW) { const int r0 = grp * 16, b = r0 / SEQ; const float* mb = mod + (size_t)b * (6 * D);
            modnorm_rows(F, x, XN, norm1_g, mb, mb + D, r0, 16); }
    }
    SEAM(1);
    if (IN(2)) {
        pg8::Gemm g{XN, Win_t, D}; pg8::StaticOrder S; S.init(M, DIN, F.G, (int)blockIdx.x);
        pg8::EpiBf16 E{PROJ, DIN};
        pg8::gemm_phase<pg8::EpiBf16, pg8::StaticOrder, true>(F.lds, g, S, E);
    }
    SEAM(2);
    if (IN(3)) {
        for (int u = blockIdx.x; u < 256; u += F.G) {
#ifndef NO_MIXB
            if (u < 128) mixer_b_unit(F, PROJ, Y, conv4_w, conv4_b, lru_w_a, lru_b_a, lru_w_x, lru_b_x, lru_lambda, hn_lru_g, u);
#endif
#ifndef NO_MIXA
            if (u >= 128) mixer_a_unit(F, PROJ, Y, conv3_w, hn_conv_g, u - 128);
#endif
        }
    }
    SEAM(3);
    if (IN(4)) {
        pg8::Gemm g{Y, Wout_t, D}; pg8::StaticOrder S; S.init(M, D, F.G, (int)blockIdx.x);
        pg8::EpiBf16 E{MIX, D};
        pg8::gemm_phase<pg8::EpiBf16, pg8::StaticOrder, true>(F.lds, g, S, E);
    }
    SEAM(4);
    if (IN(5)) {
        for (int grp = blockIdx.x; grp < M / 128; grp += F.G) { const int b = (grp * 128) / SEQ; const float* mb = mod + (size_t)b * (6 * D);
            f32x4 mu[8], ad[8];
#pragma unroll
            for (int j = 0; j < 8; ++j) { const f32x4 g = ((const f32x4*)norm2_g)[F.lane + 64 * j], sc = ((const f32x4*)(mb + 4 * D))[F.lane + 64 * j]; mu[j] = g * (1.0f + sc); ad[j] = ((const f32x4*)(mb + 3 * D))[F.lane + 64 * j]; }
#pragma unroll 1
            for (int p = 0; p < 8; ++p) p5_pass(F, x, MIX, mb + 2 * D, XN, mu, ad, wr_hi, wr_lo, rbg, rbe, grp * 128 + p * 16, rout, ltok, lwt);
        }
    }
    SEAM(5);
    if (IN(6)) {
        build_tables(F);
        pg8::Gemm g{XN, Wgu_t, D};
        pg8::GroupedOrder<4, true> S{(const LAS int*)(F.lds + TAB_OFF), (const LAS int*)(F.lds + TAB_OFF) + 80, ltok, (const unsigned*)(F.ctl + CW_CNT), F.G, F.vcu};
        pg8::EpiSwiGLU E{HB};
        pg8::gemm_phase<pg8::EpiSwiGLU, pg8::GroupedOrder<4, true>, true>(F.lds, g, S, E);
    }
    SEAM(6);
    if (IN(7)) {
        build_tables(F);
        pg8::Gemm g{HB, Wd_t, DE};
        pg8::GroupedOrder<8, false> S{(const LAS int*)(F.lds + TAB_OFF), (const LAS int*)(F.lds + TAB_OFF) + 80, ltok, (const unsigned*)(F.ctl + CW_CNT), F.G, F.vcu};
        pg8::EpiScale E{YE, lwt};
        pg8::gemm_phase<pg8::EpiScale, pg8::GroupedOrder<8, false>, true>(F.lds, g, S, E);
    }
    SEAM(7);
    if (IN(8)) {
        build_tables(F);
        const LAS int* tstart = (const LAS int*)(F.lds + TAB_OFF);
        for (int grp = gw; grp < M / 16; grp += NGW) { const int r0 = grp * 16, b = r0 / SEQ; const float* g2 = mod + (size_t)b * (6 * D) + 5 * D; const float* g1 = mod + (size_t)b * (6 * D) + 2 * D;
            f32x4 gg[8], fg[8], g1v[8];
#pragma unroll
            for (int j = 0; j < 8; ++j) { gg[j] = ((const f32x4*)g2)[F.lane + 64 * j]; fg[j] = ((const f32x4*)final_g)[F.lane + 64 * j]; g1v[j] = ((const f32x4*)g1)[F.lane + 64 * j]; }
            for (int r = r0; r < r0 + 16; ++r) {
                const int4 ro = *(const int4*)(rout + (size_t)r * 4);
                const size_t s0 = (size_t)tstart[ro.x] * 256 + ro.z, s1 = (size_t)tstart[ro.y] * 256 + ro.w;
                const v2u* y0 = (const v2u*)(YE + s0 * D) + F.lane; const v2u* y1 = (const v2u*)(YE + s1 * D) + F.lane;
                f32x4* xr = (f32x4*)(out + (size_t)r * D) + F.lane; const f32x4* xin = (const f32x4*)(x + (size_t)r * D) + F.lane; const v2u* mr = (const v2u*)(MIX + (size_t)r * D) + F.lane;
                f32x4 v[8]; float s = 0.f;
#pragma unroll
                for (int j = 0; j < 8; ++j) { const v2u a = y0[64 * j], c = y1[64 * j]; const v2u mv = mr[64 * j];
                    const f32x4 xv = xin[64 * j] + g1v[j] * (f32x4){bf_lo(mv.x), bf_hi(mv.x), bf_lo(mv.y), bf_hi(mv.y)};
                    const f32x4 ys = {bf_lo(a.x) + bf_lo(c.x), bf_hi(a.x) + bf_hi(c.x), bf_lo(a.y) + bf_lo(c.y), bf_hi(a.y) + bf_hi(c.y)};
                    v[j] = xv + gg[j] * ys; s += (v[j].x * v[j].x + v[j].y * v[j].y) + (v[j].z * v[j].z + v[j].w * v[j].w); }
                const float rstd = fast_rsq(wave_sum(s) * (1.0f / D) + EPS);
#pragma unroll
                for (int j = 0; j < 8; ++j) xr[64 * j] = v[j] * rstd * fg[j];
            }
        }
    }
#undef IN
#undef SEAM
}

extern "C" void kernel_launch(void* const* d_in, const int* in_sizes, int n_in, void* d_out, int out_size, void* d_ws, size_t ws_size, hipStream_t stream) {
    static int grid = 0;
    if (grid == 0) {
        if (n_in != 26 || in_sizes[0] != M * D || out_size != M * D || ws_size < WS_END) { fprintf(stderr, "kernel_launch: unexpected shapes (n_in %d, in0 %d, out %d, ws %zu < %zu); nothing launched\n", n_in, n_in > 0 ? in_sizes[0] : -1, out_size, ws_size, (size_t)WS_END); grid = -1; return; }
        int dev = 0, cus = 0, per_cu = 0;
        if (hipGetDevice(&dev) != hipSuccess || hipDeviceGetAttribute(&cus, hipDeviceAttributeMultiprocessorCount, dev) != hipSuccess) { fprintf(stderr, "kernel_launch: device query failed\n"); grid = -1; return; }
        if (hipFuncSetAttribute((const void*)hybrid_fwd, hipFuncAttributeMaxDynamicSharedMemorySize, LDS_BYTES) != hipSuccess) { fprintf(stderr, "kernel_launch: hipFuncSetAttribute failed\n"); grid = -1; return; }
        if (hipOccupancyMaxActiveBlocksPerMultiprocessor(&per_cu, (const void*)hybrid_fwd, NWAVES * 64, LDS_BYTES) != hipSuccess || per_cu < 1) { fprintf(stderr, "kernel_launch: occupancy query reports %d workgroups per CU\n", per_cu); }
        (void)hipGetLastError();
        grid = cus;
        if (grid % 8 != 0 || grid < 8) { fprintf(stderr, "kernel_launch: grid %d not a multiple of 8\n", grid); grid = -1; return; }
    }
    if (grid < 0) return;
    if (hipMemsetAsync((char*)d_ws + WS_CTL, 0, CTL_ZERO_BYTES, stream) != hipSuccess) { fprintf(stderr, "kernel_launch: memset failed\n"); return; }
    Args a{};
    for (int i = 0; i < 26; ++i) a.in[i] = (const float*)d_in[i];
    a.out = (float*)d_out; a.ws = (unsigned char*)d_ws;
#ifndef PROBE_REP
#define PROBE_REP -1
#endif
    for (int li = 0; li < MK_N_LAUNCHES; ++li) {
        a.ph_lo = (MK_N_LAUNCHES == 1) ? 0 : li; a.ph_hi = (MK_N_LAUNCHES == 1) ? N_PHASES : li + 1;
        if (MK_N_LAUNCHES != 1 && li == PROBE_REP) hipLaunchKernelGGL(hybrid_fwd, dim3(grid), dim3(NWAVES * 64), LDS_BYTES, stream, a);
        hipLaunchKernelGGL(hybrid_fwd, dim3(grid), dim3(NWAVES * 64), LDS_BYTES, stream, a);
        const hipError_t le = hipPeekAtLastError();
        if (le != hipSuccess) { fprintf(stderr, "kernel_launch: launch %d failed: %s\n", li, hipGetErrorName(le)); break; }
    }
}
```

```cpp
#include <hip/hip_runtime.h>
#include <cstdio>
#include <cstdint>

#ifndef MK_N_LAUNCHES
#define MK_N_LAUNCHES 1
#endif

constexpr int D = 2048, NB = 16, SEQ = 2048, M = NB * SEQ;
constexpr int DC = 1024, DL = 1024, DIN = 5120;
constexpr int CONV_HD = 64, LRU_HEADS = 8, LRU_HD = 128;
constexpr int NE = 64, NGRP = 8, EPG = 8, DE = 512;
constexpr int NRC = 80;
constexpr float EPS = 1e-6f;
constexpr int MT_MAX = (2 * M) / 256 + NE;
constexpr int LISTCAP = M;
constexpr float S_WGU = 32.f, S_WD = 16.f, S_H = 16.f, S_Y = 64.f;

constexpr size_t MiB = 1u << 20;
constexpr size_t WS_CTL = 0, CTL_ZERO_BYTES = 1 * MiB;
constexpr size_t WS_MOD = 1 * MiB;
constexpr size_t WS_ROUT = 2 * MiB;
constexpr size_t WS_WR = 3 * MiB;
constexpr size_t WS_LTOK = 4 * MiB;
constexpr size_t WS_LW = 12 * MiB;
constexpr size_t WS_WIN = 20 * MiB;
constexpr size_t WS_WOUT = 40 * MiB;
constexpr size_t WS_WGU = 48 * MiB;
constexpr size_t WS_X1B = 176 * MiB;
constexpr size_t WS_WD = 304 * MiB;
constexpr size_t WS_XN = 432 * MiB;
constexpr size_t WS_PROJ = 560 * MiB;
constexpr size_t WS_Y = 880 * MiB;
constexpr size_t WS_PART = 368 * MiB;
constexpr size_t WS_MIX = 1008 * MiB;
constexpr size_t WS_END = 1136 * MiB;
constexpr int CW_BAR = 4096;
constexpr int CW_FLG = 65536;
constexpr int CW_Q = 12288;
constexpr int CW_CNT = 16384;

constexpr int RING_BYTES = 131072;
constexpr int LDSCTL_OFF = 143360;
constexpr int LDS_BYTES = 147456;
constexpr int MISC_OFF = LDSCTL_OFF;
constexpr int TAB_OFF = LDSCTL_OFF + 256;
constexpr int NWAVES = 8;

#define GAS __attribute__((address_space(1)))
#define LAS __attribute__((address_space(3)))
typedef unsigned short bf16;
typedef unsigned v4u __attribute__((ext_vector_type(4)));
typedef unsigned v2u __attribute__((ext_vector_type(2)));
typedef float f32x4 __attribute__((ext_vector_type(4)));
typedef float f32x2 __attribute__((ext_vector_type(2)));
typedef float f32x16 __attribute__((ext_vector_type(16)));
typedef short bf16x8 __attribute__((ext_vector_type(8)));
typedef __bf16 bf16x2_t __attribute__((ext_vector_type(2)));
typedef int v4i_t __attribute__((ext_vector_type(4)));
typedef int v8i_t __attribute__((ext_vector_type(8)));
typedef GAS unsigned gu32;
#define RLX_AGENT __ATOMIC_RELAXED, __HIP_MEMORY_SCOPE_AGENT
#define LDS_WAIT() asm volatile("s_waitcnt lgkmcnt(0)" ::: "memory")
#define VM_WAIT() asm volatile("s_waitcnt vmcnt(0)" ::: "memory")

__device__ __forceinline__ unsigned cvtpk(float lo, float hi) { f32x2 v = {lo, hi}; bf16x2_t b = __builtin_convertvector(v, bf16x2_t); return __builtin_bit_cast(unsigned, b); }
__device__ __forceinline__ float clamp448(float v) { return __builtin_fminf(__builtin_fmaxf(v, -448.f), 448.f); }
__device__ __forceinline__ unsigned cvt4_fp8(float a, float b, float c, float d) {
    int p = __builtin_amdgcn_cvt_pk_fp8_f32(clamp448(a), clamp448(b), 0, false); p = __builtin_amdgcn_cvt_pk_fp8_f32(clamp448(c), clamp448(d), p, true); return (unsigned)p; }
__device__ __forceinline__ float bf_lo(unsigned w) { return __builtin_bit_cast(float, w << 16); }
__device__ __forceinline__ float bf_hi(unsigned w) { return __builtin_bit_cast(float, w & 0xffff0000u); }
__device__ __forceinline__ float bf2f(bf16 b) { return __builtin_bit_cast(float, ((unsigned)b) << 16); }
__device__ __forceinline__ float fast_rcp(float x) { return __builtin_amdgcn_rcpf(x); }
__device__ __forceinline__ float fast_exp(float x) { return __builtin_amdgcn_exp2f(x * 1.44269504089f); }
__device__ __forceinline__ float fast_sqrt(float x) { return __builtin_amdgcn_sqrtf(x); }
__device__ __forceinline__ float fast_rsq(float x) { return __builtin_amdgcn_rsqf(x); }
__device__ __forceinline__ float sigmoidf_(float x) { return fast_rcp(1.0f + fast_exp(-x)); }
__device__ __forceinline__ float wave_sum(float v) {
#pragma unroll
    for (int o = 1; o < 64; o <<= 1) v += __shfl_xor(v, o);
    return v;
}

namespace pg8 {
constexpr int BM = 256, BK = 64, HALF = 128, HTB = HALF * BK * 2, STAGE_BYTES = 8 * HTB, NXCD = 8, WGM = 8;
constexpr int ROWTAB_OFF = STAGE_BYTES;
__host__ __device__ __forceinline__ int lds_byte(int r, int c) { const int st = (r >> 4) * 2 + (c >> 5), rr = r & 15, cc = c & 31, ob = rr * 64 + cc * 2; return st * 1024 + (ob ^ (((ob >> 9) & 1) << 5)); }
__host__ __device__ __forceinline__ void stage_rc(int b, int& R, int& C) { const int st = b / 1024, sb = b % 1024, swz = sb ^ (((sb >> 9) & 1) << 5); R = (st >> 1) * 16 + swz / 64; C = (st & 1) * 32 + (swz % 64) / 2; }
__host__ __device__ __forceinline__ int perm32(int rho) { const int n = rho >> 4, i = rho & 15; return 8 * (i >> 2) + 4 * n + (i & 3); }

struct Unit { int pm, pn, e, r0, cnt, nt; };
struct Gemm { const void* A; const void* Bt; int RB; };

struct StaticOrder {
    static constexpr bool UNIT_OFF = false;
    static constexpr bool GROUPED = false;
    int nM, nN, nwg, G, c;
    __device__ void init(int M_, int N_, int G_, int c_) { nM = M_ / BM; nN = N_ / BM; nwg = nM * nN; G = G_; c = c_; }
    __device__ __forceinline__ bool next(int i, Unit& u) const {
        const long L = (long)i * G + c; if (L >= nwg) return false;
        int wgid = (int)L; { const int q = nwg / NXCD, r = nwg % NXCD, xcd = wgid % NXCD, off = wgid / NXCD; wgid = (xcd < r ? xcd * (q + 1) : r * (q + 1) + (xcd - r) * q) + off; }
        const int nig = WGM * nN, gid = wgid / nig, fm = gid * WGM, gsz = (nM - fm) < WGM ? (nM - fm) : WGM;
        u.pm = fm + ((wgid % nig) % gsz); u.pn = (wgid % nig) / gsz; u.e = 0; u.r0 = 0; u.cnt = 0; u.nt = 0; return true;
    }
    __device__ __forceinline__ void a_off(const Unit&, const int (&R)[2], const int (&C)[2], int RB, unsigned (&o)[2][2]) const {
#pragma unroll
        for (int h = 0; h < 2; ++h)
#pragma unroll
            for (int i = 0; i < 2; ++i) o[h][i] = (unsigned)((h * HALF + R[i]) * RB + C[i] * 2);
    }
    __device__ __forceinline__ const char* a_base(const Gemm& g, const Unit& u) const { return (const char*)g.A + (size_t)u.pm * ((size_t)BM * g.RB); }
};
template <int NT, bool GATHER> struct GroupedOrder {
    static constexpr bool UNIT_OFF = GATHER;
    static constexpr bool GROUPED = true;
    const LAS int* tstart; const LAS int* texp; const int* ltok; const unsigned* cnt; int G, vcu;
    __device__ __forceinline__ bool next(int i, Unit& u) const {
        const int total = __builtin_amdgcn_readfirstlane(tstart[NE]) * NT;
        const int gx = G >> 3, x = vcu / gx, j = vcu % gx;
        const int per = (total + 7) >> 3, q = x * per + j + i * gx;
        if (j + i * gx >= per || q >= total) return false;
        const int mt = q / NT; u.nt = q % NT; u.pm = mt;
        const int e = __builtin_amdgcn_readfirstlane(texp[mt]); u.e = e; u.pn = e * NT + u.nt;
        u.r0 = (mt - __builtin_amdgcn_readfirstlane(tstart[e])) * BM;
        u.cnt = __builtin_amdgcn_readfirstlane(tstart[80 + MT_MAX + e]);
        return true;
    }
    __device__ __forceinline__ void a_off(const Unit& u, const int (&R)[2], const int (&C)[2], int RB, unsigned (&o)[2][2]) const {
#pragma unroll
        for (int h = 0; h < 2; ++h)
#pragma unroll
            for (int i = 0; i < 2; ++i) {
                if (GATHER) { const int rie = u.r0 + h * HALF + R[i]; const int tok = rie < u.cnt ? (ltok[(size_t)u.e * LISTCAP + rie] >> 1) : 0; o[h][i] = (unsigned)(tok * RB + C[i] * 2); }
                else o[h][i] = (unsigned)((h * HALF + R[i]) * RB + C[i] * 2);
            }
    }
    __device__ __forceinline__ const char* a_base(const Gemm& g, const Unit& u) const { return GATHER ? (const char*)g.A : (const char*)g.A + (size_t)u.pm * ((size_t)BM * g.RB); }
};

struct EpiBf16 {
    static constexpr bool PERM = true; static constexpr bool ROWTAB = false;
    bf16* O; int ldc;
    __device__ __forceinline__ void operator()(const f32x4 (&acc)[2][2][4][2], const Unit& u, int wr, int wc, int fr, int fq) const {
        const int row0 = u.pm * BM + wr * 64 + fr, col0 = u.pn * BM + wc * 32 + 8 * fq;
#pragma unroll
        for (int ai = 0; ai < 2; ++ai)
#pragma unroll
            for (int m = 0; m < 4; ++m) { bf16* rowp = O + (size_t)(row0 + ai * HALF + m * 16) * ldc + col0;
#pragma unroll
                for (int bj = 0; bj < 2; ++bj) { const f32x4 v0 = acc[ai][bj][m][0], v1 = acc[ai][bj][m][1];
                    v4u w; w.x = cvtpk(v0[0], v0[1]); w.y = cvtpk(v0[2], v0[3]); w.z = cvtpk(v1[0], v1[1]); w.w = cvtpk(v1[2], v1[3]);
                    *(v4u*)(rowp + bj * HALF) = w; } }
    }
};
struct EpiResid {
    static constexpr bool PERM = true; static constexpr bool ROWTAB = false;
    bf16* O; const float* x; const float* mod;
    __device__ __forceinline__ void operator()(const f32x4 (&acc)[2][2][4][2], const Unit& u, int wr, int wc, int fr, int fq) const {
        const int row0 = u.pm * BM + wr * 64 + fr, col0 = u.pn * BM + wc * 32 + 8 * fq;
        const float* gp = mod + (size_t)((u.pm * BM) / SEQ) * (6 * D) + 2 * D + col0;
        f32x4 g[2][2];
#pragma unroll
        for (int bj = 0; bj < 2; ++bj) { g[bj][0] = *(const f32x4*)(gp + bj * HALF); g[bj][1] = *(const f32x4*)(gp + bj * HALF + 4); }
#pragma unroll
        for (int ai = 0; ai < 2; ++ai) {
            const GAS float* xp = (const GAS float*)x + (size_t)(row0 + ai * HALF) * D + col0; GAS bf16* op = (GAS bf16*)O + (size_t)(row0 + ai * HALF) * D + col0;
            asm volatile("" : "+v"(xp), "+v"(op));
            f32x4 xv[4][2][2];
#pragma unroll
            for (int m = 0; m < 4; ++m)
#pragma unroll
                for (int bj = 0; bj < 2; ++bj) { xv[m][bj][0] = __builtin_nontemporal_load((const GAS f32x4*)(xp + (size_t)(m * 16) * D + bj * HALF)); xv[m][bj][1] = __builtin_nontemporal_load((const GAS f32x4*)(xp + (size_t)(m * 16) * D + bj * HALF + 4)); }
#pragma unroll
            for (int m = 0; m < 4; ++m)
#pragma unroll
                for (int bj = 0; bj < 2; ++bj) { const f32x4 v0 = xv[m][bj][0] + g[bj][0] * acc[ai][bj][m][0], v1 = xv[m][bj][1] + g[bj][1] * acc[ai][bj][m][1];
                    v4u w; w.x = cvtpk(v0[0], v0[1]); w.y = cvtpk(v0[2], v0[3]); w.z = cvtpk(v1[0], v1[1]); w.w = cvtpk(v1[2], v1[3]);
                    *(GAS v4u*)(op + (size_t)(m * 16) * D + bj * HALF) = w; }
        }
    }
};
struct EpiSwiGLU {
    static constexpr bool PERM = true; static constexpr bool ROWTAB = true;
    unsigned char* H; const float* lw;
    __device__ __forceinline__ const unsigned* rowtab(const Unit& u, int row) const { const int rie = u.r0 + row; return (const unsigned*)(lw + (size_t)u.e * LISTCAP + (rie < LISTCAP ? rie : LISTCAP - 1)); }
    __device__ __forceinline__ void operator()(const f32x4 (&acc)[2][2][4][2], const Unit& u, int wr, int wc, int fr, int fq, const LAS unsigned* tab) const {
        const int rt0 = wr * 64 + fr, col0 = u.nt * HALF + wc * 32 + 8 * fq;
        float wv[2][4];
#pragma unroll
        for (int ai = 0; ai < 2; ++ai)
#pragma unroll
            for (int m = 0; m < 4; ++m) { const int row = rt0 + ai * HALF + m * 16; wv[ai][m] = (u.r0 + row) < u.cnt ? __builtin_bit_cast(float, tab[row]) : 0.f; }
#pragma unroll
        for (int ai = 0; ai < 2; ++ai)
#pragma unroll
            for (int m = 0; m < 4; ++m) { unsigned char* rowp = H + (size_t)(u.pm * BM + rt0 + ai * HALF + m * 16) * DE + col0; const float sw = wv[ai][m];
                float h[8];
#pragma unroll
                for (int n = 0; n < 2; ++n)
#pragma unroll
                    for (int j = 0; j < 4; ++j) { const float g = acc[ai][0][m][n][j] * (1.0f / S_WGU), up = acc[ai][1][m][n][j] * (S_H / S_WGU); h[n * 4 + j] = g * sigmoidf_(g) * (up * sw); }
                v2u w; w.x = cvt4_fp8(h[0], h[1], h[2], h[3]); w.y = cvt4_fp8(h[4], h[5], h[6], h[7]);
                *(v2u*)rowp = w; }
    }
};
struct EpiF8G {
    static constexpr bool PERM = true; static constexpr bool ROWTAB = true;
    unsigned char* O; const int* ltok;
    __device__ __forceinline__ const unsigned* rowtab(const Unit& u, int row) const { const int rie = u.r0 + row; return (const unsigned*)(ltok + (size_t)u.e * LISTCAP + (rie < LISTCAP ? rie : LISTCAP - 1)); }
    __device__ __forceinline__ void operator()(const f32x4 (&acc)[2][2][4][2], const Unit& u, int wr, int wc, int fr, int fq, const LAS unsigned* tab) const {
        const int rt0 = wr * 64 + fr, col0 = u.nt * BM + wc * 32 + 8 * fq;
        constexpr float sc = S_Y / (S_H * S_WD);
#pragma unroll
        for (int ai = 0; ai < 2; ++ai) { int dr[4];
#pragma unroll
            for (int m = 0; m < 4; ++m) { const int row = rt0 + ai * HALF + m * 16; dr[m] = (u.r0 + row) < u.cnt ? (int)tab[row] : 2 * M; }
#pragma unroll
            for (int m = 0; m < 4; ++m) { unsigned char* rowp = O + (size_t)dr[m] * D + col0;
#pragma unroll
                for (int bj = 0; bj < 2; ++bj) { const f32x4 v0 = acc[ai][bj][m][0] * sc, v1 = acc[ai][bj][m][1] * sc;
                    v2u w; w.x = cvt4_fp8(v0[0], v0[1], v0[2], v0[3]); w.y = cvt4_fp8(v1[0], v1[1], v1[2], v1[3]);
                    *(v2u*)(rowp + bj * HALF) = w; } }
            asm volatile("" ::: "memory"); }
    }
};

template <class Epi, class Sched, bool ALIGN_EPI, bool F8 = false>
__device__ __forceinline__ void gemm_phase(LAS unsigned char* lds, const Gemm g, const Sched& S, const Epi& E) {
    const int tid = threadIdx.x, wid = __builtin_amdgcn_readfirstlane(tid >> 6), lane = tid & 63, wr = wid >> 2, wc = wid & 3, fr = lane & 15, fq = lane >> 4;
    const int K = g.RB, nt = K / (BK * 2);
    int Rr[2], Cc[2]; unsigned voffB[2];
#pragma unroll
    for (int i = 0; i < 2; ++i) { int R, C; stage_rc(tid * 16 + i * 8192, R, C); const int Rb = Epi::PERM ? ((R & ~31) + perm32(R & 31)) : R; Rr[i] = R; Cc[i] = C; voffB[i] = (unsigned)(Rb * K + C * 2); }
    const size_t kstep = (size_t)(BK * 2);
    const size_t hstep = (size_t)HALF * K;
    const size_t tstep = 2 * hstep;
    const unsigned ldsw = (unsigned)wid * 1024u;
    const int aoff = lds_byte(wr * 64 + fr, fq * 8), boff = lds_byte(wc * 32 + fr, fq * 8);
#define PG8_SA(b, h) (((b) * 2 + (h)) * HTB)
#define PG8_SB(b, h) ((4 + (b) * 2 + (h)) * HTB)
#define PG8_STAGE(bufoff, gbase, voff) do { _Pragma("unroll") for (int _i = 0; _i < 2; ++_i) \
        __builtin_amdgcn_global_load_lds((const unsigned*)((const char*)(gbase) + (voff)[_i]), (LAS unsigned*)(lds + (bufoff) + ldsw + _i * 8192), 16, 0, 0); } while (0)
#define PG8_LDA(dst, b, h) do { if constexpr (F8) { _Pragma("unroll") for (int m = 0; m < 4; ++m) dst##8[m] = __builtin_shufflevector(*(const LAS v4i_t*)(lds + PG8_SA(b, h) + aoff + m * 2048), *(const LAS v4i_t*)(lds + PG8_SA(b, h) + aoff + m * 2048 + 1024), 0, 1, 2, 3, 4, 5, 6, 7); } \
        else { _Pragma("unroll") for (int m = 0; m < 4; ++m) _Pragma("unroll") for (int k = 0; k < 2; ++k) dst[m][k] = *(const LAS bf16x8*)(lds + PG8_SA(b, h) + aoff + m * 2048 + k * 1024); } } while (0)
#define PG8_LDB(dst, b, h) do { if constexpr (F8) { _Pragma("unroll") for (int n = 0; n < 2; ++n) dst##8[n] = __builtin_shufflevector(*(const LAS v4i_t*)(lds + PG8_SB(b, h) + boff + n * 2048), *(const LAS v4i_t*)(lds + PG8_SB(b, h) + boff + n * 2048 + 1024), 0, 1, 2, 3, 4, 5, 6, 7); } \
        else { _Pragma("unroll") for (int n = 0; n < 2; ++n) _Pragma("unroll") for (int k = 0; k < 2; ++k) dst[n][k] = *(const LAS bf16x8*)(lds + PG8_SB(b, h) + boff + n * 2048 + k * 1024); } } while (0)
#define PG8_MMA(ai, bj, At, Bt) do { __builtin_amdgcn_s_setprio(1); _Pragma("unroll") for (int m = 0; m < 4; ++m) _Pragma("unroll") for (int n = 0; n < 2; ++n) { \
        if constexpr (F8) {   \
              \
            if (m == 0 && n == 0) asm volatile("s_nop 1\n\tv_mfma_scale_f32_16x16x128_f8f6f4 %0, %1, %2, %0, %3, %3 op_sel_hi:[0,0,0]" : "+v"(acc[ai][bj][m][n]) : "v"(Bt##8[n]), "v"(At##8[m]), "v"(sc1)); \
            else asm volatile("v_mfma_scale_f32_16x16x128_f8f6f4 %0, %1, %2, %0, %3, %3 op_sel_hi:[0,0,0]" : "+v"(acc[ai][bj][m][n]) : "v"(Bt##8[n]), "v"(At##8[m]), "v"(sc1)); \
        } else { _Pragma("unroll") for (int k = 0; k < 2; ++k) acc[ai][bj][m][n] = __builtin_amdgcn_mfma_f32_16x16x32_bf16(Bt[n][k], At[m][k], acc[ai][bj][m][n], 0, 0, 0); } } \
        __builtin_amdgcn_s_setprio(0); } while (0)
#define PG8_WAIT_V(n) asm volatile("s_waitcnt vmcnt(" #n ")" ::: "memory")
#define PG8_WAIT_L(n) asm volatile("s_waitcnt lgkmcnt(" #n ")" ::: "memory")
#define PG8_BAR __builtin_amdgcn_s_barrier()
#define PG8_SCHED __builtin_amdgcn_sched_barrier(0)
    Unit cur, nxt; int ui = 0;
    if (!S.next(0, cur)) return;
    f32x4 acc[2][2][4][2];
#pragma unroll
    for (int a = 0; a < 2; ++a)
#pragma unroll
        for (int b = 0; b < 2; ++b)
#pragma unroll
            for (int m = 0; m < 4; ++m)
#pragma unroll
                for (int n = 0; n < 2; ++n) acc[a][b][m][n] = (f32x4){0.f, 0.f, 0.f, 0.f};
    const int sc1 = 0x7f7f7f7f;
    bf16x8 At[4][2], B0[2][2], B1[2][2]; v8i_t At8[4], B08[2], B18[2];
    unsigned cO[2][2], nO[2][2];
    S.a_off(cur, Rr, Cc, K, cO);
    const char* cA = S.a_base(g, cur); const char* cB = (const char*)g.Bt + (size_t)cur.pn * tstep;
    PG8_STAGE(PG8_SB(0, 0), cB, voffB); PG8_STAGE(PG8_SB(0, 1), cB + hstep, voffB); PG8_STAGE(PG8_SA(0, 0), cA, cO[0]); PG8_STAGE(PG8_SA(0, 1), cA, cO[1]);
    if (wr == 1) PG8_BAR;
    PG8_WAIT_V(2); PG8_BAR;
    PG8_STAGE(PG8_SB(1, 0), cB + kstep, voffB); PG8_STAGE(PG8_SA(1, 0), cA + kstep, cO[0]); PG8_STAGE(PG8_SB(1, 1), cB + hstep + kstep, voffB);
    PG8_WAIT_V(6); PG8_BAR;
    for (;;) {
        if constexpr (Epi::ROWTAB) { if (wid < 4) __builtin_amdgcn_global_load_lds(E.rowtab(cur, wid * 64 + lane), (LAS unsigned*)(lds + ROWTAB_OFF + (ui & 1) * 1024 + wid * 256), 4, 0, 0); }
        const bool has_next = S.next(ui + 1, nxt);
        const char* nA = cA; const char* nB = cB;
        if constexpr (Sched::UNIT_OFF) {
#pragma unroll
            for (int h = 0; h < 2; ++h)
#pragma unroll
                for (int i = 0; i < 2; ++i) nO[h][i] = cO[h][i];
        }
        if (has_next) { if constexpr (Sched::UNIT_OFF) S.a_off(nxt, Rr, Cc, K, nO); nA = S.a_base(g, nxt); nB = (const char*)g.Bt + (size_t)nxt.pn * tstep; }
        const bool half_unit = Sched::GROUPED && (cur.cnt - cur.r0) <= HALF;
#pragma unroll 1
        for (int t = 0; t < nt; t += 2) {
            const bool last = (t == nt - 2);
            const char* a1 = cA + (size_t)(t + 1) * kstep;
            const char* a2 = last ? nA : cA + (size_t)(t + 2) * kstep; const char* b2 = last ? nB : cB + (size_t)(t + 2) * kstep;
            const char* a3 = a2 + kstep; const char* b3 = b2 + kstep;
            unsigned o2[2][2];
#pragma unroll
            for (int h = 0; h < 2; ++h)
#pragma unroll
                for (int i = 0; i < 2; ++i) o2[h][i] = (Sched::UNIT_OFF && last) ? nO[h][i] : cO[h][i];
            PG8_LDB(B0, 0, 0); PG8_LDB(B1, 0, 1); PG8_SCHED; PG8_LDA(At, 0, 0); PG8_STAGE(PG8_SA(1, 1), a1, cO[1]);
            PG8_WAIT_V(8); PG8_WAIT_L(0); PG8_BAR; PG8_MMA(0, 0, At, B0); PG8_MMA(0, 1, At, B1); PG8_BAR; PG8_SCHED;
            PG8_LDA(At, 0, 1); PG8_STAGE(PG8_SB(0, 0), b2, voffB); PG8_STAGE(PG8_SB(0, 1), b2 + hstep, voffB); PG8_STAGE(PG8_SA(0, 0), a2, o2[0]);
            PG8_WAIT_V(8); PG8_WAIT_L(0); PG8_BAR; if (!half_unit) { PG8_MMA(1, 0, At, B0); PG8_MMA(1, 1, At, B1); } PG8_BAR; PG8_SCHED;
            PG8_LDB(B0, 1, 0); PG8_LDB(B1, 1, 1); PG8_SCHED; PG8_LDA(At, 1, 0); PG8_STAGE(PG8_SA(0, 1), a2, o2[1]);
            PG8_WAIT_V(8); PG8_WAIT_L(0); PG8_BAR; PG8_MMA(0, 0, At, B0); PG8_MMA(0, 1, At, B1); PG8_BAR; PG8_SCHED;
            PG8_LDA(At, 1, 1); PG8_STAGE(PG8_SB(1, 0), b3, voffB); PG8_STAGE(PG8_SB(1, 1), b3 + hstep, voffB); PG8_STAGE(PG8_SA(1, 0), a3, o2[0]);
            PG8_WAIT_V(8); PG8_WAIT_L(0); PG8_BAR; if (!half_unit) { PG8_MMA(1, 0, At, B0); PG8_MMA(1, 1, At, B1); } PG8_BAR; PG8_SCHED;
        }
        if constexpr (ALIGN_EPI) { if (wr == 0) PG8_BAR; }
        if constexpr (F8) asm volatile("s_nop 15\n\ts_nop 7" ::: "memory");
        if constexpr (Epi::ROWTAB) E(acc, cur, wr, wc, fr, fq, (const LAS unsigned*)(lds + ROWTAB_OFF + (ui & 1) * 1024)); else E(acc, cur, wr, wc, fr, fq);
        if (!has_next) break;
#pragma unroll
        for (int a = 0; a < 2; ++a)
#pragma unroll
            for (int b = 0; b < 2; ++b)
#pragma unroll
                for (int m = 0; m < 4; ++m)
#pragma unroll
                    for (int n = 0; n < 2; ++n) acc[a][b][m][n] = (f32x4){0.f, 0.f, 0.f, 0.f};
        cur = nxt; cA = nA; cB = nB; ++ui;
        if constexpr (Sched::UNIT_OFF) {
#pragma unroll
            for (int h = 0; h < 2; ++h)
#pragma unroll
                for (int i = 0; i < 2; ++i) cO[h][i] = nO[h][i];
        }
        if constexpr (ALIGN_EPI) { if (wr == 1) PG8_BAR; }
    }
    PG8_WAIT_V(0);
    if constexpr (!ALIGN_EPI) { if (wr == 0) PG8_BAR; }
    PG8_BAR;
#undef PG8_SA
#undef PG8_SB
#undef PG8_STAGE
#undef PG8_LDA
#undef PG8_LDB
#undef PG8_MMA
#undef PG8_WAIT_V
#undef PG8_WAIT_L
#undef PG8_BAR
#undef PG8_SCHED
}
}

#define XB_TMO      128
#define XB_XCNT(j)  (256  + 64 * (j))
#define XB_XSUB(j)  (1280 + 64 * (j))
#define XB_XGEN(j)  (2304 + 64 * (j))
#define XB_TOP      3328
#define XB_TOPGEN   3392
#define XCD_BAR_WORDS 3456
#define XB_SPIN_CAP (1u << 18)
__device__ __forceinline__ unsigned xb_ld(unsigned* p)              { return __hip_atomic_load(p, __ATOMIC_RELAXED, __HIP_MEMORY_SCOPE_AGENT); }
__device__ __forceinline__ unsigned xb_add(unsigned* p, unsigned v) { return __hip_atomic_fetch_add(p, v, __ATOMIC_RELAXED, __HIP_MEMORY_SCOPE_AGENT); }
__device__ __forceinline__ unsigned xb_xcc_id() { return (unsigned)__builtin_amdgcn_s_getreg((3 << 11) | 20) & 0xFu; }
#define XB_SPIN(cond, bar) do { unsigned _sp = 0; while (cond) { __builtin_amdgcn_s_sleep(1); \
    if ((++_sp & 255u) == 0u) { if (xb_ld(&(bar)[XB_TMO])) break; if (_sp > XB_SPIN_CAP) { atomicAdd(&(bar)[XB_TMO], 1u); break; } } } } while (0)
struct XcdBarrier { unsigned* bar; unsigned x; volatile LAS unsigned* st; };
__device__ __forceinline__ XcdBarrier xcd_barrier_post(unsigned* bar, volatile LAS unsigned* st) {
    XcdBarrier b; b.bar = bar; b.x = xb_xcc_id(); b.st = st;
    if (threadIdx.x == 0) (void)xb_add(&bar[XB_XCNT(b.x)], 1u);
    return b;
}
__device__ __forceinline__ void xcd_barrier_complete(unsigned* bar, unsigned x, unsigned& nloc, unsigned& nx) {
    const unsigned G = gridDim.x * gridDim.y * gridDim.z;
    unsigned sum, cnt, mine, sp = 0u;
    for (;;) {
        sum = 0u; cnt = 0u; mine = 0u;
#pragma unroll
        for (unsigned j = 0; j < 16; ++j) { const unsigned c = xb_ld(&bar[XB_XCNT(j)]); sum += c; cnt += (c > 0u) ? 1u : 0u; mine = (j == x) ? c : mine; }
        if (sum == G) break;
        __builtin_amdgcn_s_sleep(1);
        if ((++sp & 255u) == 0u) { if (xb_ld(&bar[XB_TMO])) break; if (sp > XB_SPIN_CAP) { atomicAdd(&bar[XB_TMO], 1u); break; } }
    }
    nloc = mine > 0u ? mine : 1u; nx = cnt > 0u ? cnt : 1u;
}
__device__ __forceinline__ void xcd_barrier(const XcdBarrier& b) {
    asm volatile("s_waitcnt vmcnt(0)" ::: "memory");
    __syncthreads();
    if (threadIdx.x == 0) {
        unsigned* bar = b.bar;
        __builtin_amdgcn_s_waitcnt(0);
        unsigned nloc = b.st[0], nx = b.st[1];
        if (nloc == 0u) { xcd_barrier_complete(bar, b.x, nloc, nx); b.st[0] = nloc; b.st[1] = nx; }
        const unsigned old = xb_add(&bar[XB_XSUB(b.x)], 1u);
        const unsigned gen = old / nloc;
        if (old + 1u == (gen + 1u) * nloc) {
            __builtin_amdgcn_fence(__ATOMIC_RELEASE, "agent");
            asm volatile("s_waitcnt vmcnt(0)" ::: "memory");
            const unsigned og = xb_add(&bar[XB_TOP], 1u);
            const unsigned tg = og / nx;
            if (og + 1u == (tg + 1u) * nx) xb_add(&bar[XB_TOPGEN], 1u);
            else XB_SPIN(xb_ld(&bar[XB_TOPGEN]) == tg, bar);
            __builtin_amdgcn_fence(__ATOMIC_ACQUIRE, "agent");
            xb_add(&bar[XB_XGEN(b.x)], 1u);
            asm volatile("s_waitcnt vmcnt(0)" ::: "memory");
        } else {
            XB_SPIN(xb_ld(&bar[XB_XGEN(b.x)]) == gen, bar);
            __builtin_amdgcn_fence(__ATOMIC_ACQUIRE, "agent");
            asm volatile("s_waitcnt vmcnt(0)" ::: "memory");
        }
    }
    __syncthreads();
}

struct Frame {
    LAS unsigned char* lds;
    volatile LAS unsigned* MISC;
    gu32* ctl;
    int tid, lane, wave, vcu, G;
};
struct Args {
    const float* in[26]; float* out; unsigned char* ws; int ph_lo, ph_hi;
};

__device__ __forceinline__ void p0_transpose_item(const float* W, int N, int k0, int n0, bf16* WT, size_t drow0, int Kd, LAS float* scr, int lane) {
    const int lq = lane & 15, lk = lane >> 4;
#pragma unroll 8
    for (int i = 0; i < 16; ++i) { const int kk = 4 * i + lk; const f32x4 v = *(const f32x4*)(W + (size_t)(k0 + kk) * N + n0 + 4 * lq);
        LAS float* s = scr + kk * 65 + 4 * lq; s[0] = v.x; s[1] = v.y; s[2] = v.z; s[3] = v.w; }
    LDS_WAIT(); asm volatile("" ::: "memory");
    const int c = lane & 7;
#pragma unroll
    for (int j = 0; j < 8; ++j) { const int n = (lane >> 3) + 8 * j; const LAS float* s = scr + (8 * c) * 65 + n;
        v4u o; o.x = cvtpk(s[0 * 65], s[1 * 65]); o.y = cvtpk(s[2 * 65], s[3 * 65]); o.z = cvtpk(s[4 * 65], s[5 * 65]); o.w = cvtpk(s[6 * 65], s[7 * 65]);
        *(v4u*)(WT + (drow0 + n) * (size_t)Kd + k0 + 8 * c) = o; }
    LDS_WAIT(); asm volatile("" ::: "memory");
}
__device__ __forceinline__ void p0_transpose_item_f8(const float* W, int N, int k0, int n0, unsigned char* W8, size_t drow0, int Kd, float sc, LAS float* scr, int lane) {
    const int lq = lane & 15, lk = lane >> 4;
#pragma unroll 8
    for (int i = 0; i < 16; ++i) { const int kk = 4 * i + lk; const f32x4 v = *(const f32x4*)(W + (size_t)(k0 + kk) * N + n0 + 4 * lq);
        LAS float* s = scr + kk * 65 + 4 * lq; s[0] = v.x * sc; s[1] = v.y * sc; s[2] = v.z * sc; s[3] = v.w * sc; }
    LDS_WAIT(); asm volatile("" ::: "memory");
    const int c = lane & 3;
#pragma unroll
    for (int j = 0; j < 4; ++j) { const int n = (lane >> 2) + 16 * j; const LAS float* s = scr + (16 * c) * 65 + n;
        v4u o; o.x = cvt4_fp8(s[0 * 65], s[1 * 65], s[2 * 65], s[3 * 65]); o.y = cvt4_fp8(s[4 * 65], s[5 * 65], s[6 * 65], s[7 * 65]);
        o.z = cvt4_fp8(s[8 * 65], s[9 * 65], s[10 * 65], s[11 * 65]); o.w = cvt4_fp8(s[12 * 65], s[13 * 65], s[14 * 65], s[15 * 65]);
        *(v4u*)(W8 + (drow0 + n) * (size_t)Kd + k0 + 16 * c) = o; }
    LDS_WAIT(); asm volatile("" ::: "memory");
}
constexpr int P0_I_IN = (D / 64) * (DIN / 64), P0_I_OUT = (D / 64) * (D / 64), P0_NITEMS = P0_I_IN + P0_I_OUT, P0_SPARE_ITEMS = 1920;
struct TrItem { const float* src; bf16* dst; int N; };
__device__ __forceinline__ TrItem tr_item(int r, const float* w_in, const float* w_out, bf16* Win_t, bf16* Wout_t) {
    TrItem c;
    if (r < P0_I_IN) { const int nb = r % (DIN / 64), kb = r / (DIN / 64); c.src = w_in + (size_t)(kb * 64) * DIN + nb * 64; c.dst = Win_t + (size_t)(nb * 64) * D + kb * 64; c.N = DIN; }
    else { r -= P0_I_IN; const int nb = r % (D / 64), kb = r / (D / 64); c.src = w_out + (size_t)(kb * 64) * D + nb * 64; c.dst = Wout_t + (size_t)(nb * 64) * D + kb * 64; c.N = D; }
    return c;
}
__device__ __forceinline__ void tr_load(const TrItem& c, f32x4 (&v)[16], int lane) { const int lq = lane & 15, lk = lane >> 4;
#pragma unroll
    for (int i = 0; i < 16; ++i) v[i] = __builtin_nontemporal_load((const f32x4*)(c.src + (size_t)(16 * lk + i) * c.N + 4 * lq)); }
__device__ __forceinline__ void tr_store(const TrItem& c, const f32x4 (&v)[16], int lane) { const int lq = lane & 15, lk = lane >> 4;
    bf16* dp = c.dst + (size_t)(4 * lq) * D + 16 * lk;
#pragma unroll
    for (int j = 0; j < 4; ++j) { v4u o0, o1;
        o0.x = cvtpk(v[0][j], v[1][j]); o0.y = cvtpk(v[2][j], v[3][j]); o0.z = cvtpk(v[4][j], v[5][j]); o0.w = cvtpk(v[6][j], v[7][j]);
        o1.x = cvtpk(v[8][j], v[9][j]); o1.y = cvtpk(v[10][j], v[11][j]); o1.z = cvtpk(v[12][j], v[13][j]); o1.w = cvtpk(v[14][j], v[15][j]);
        *(v4u*)(dp + (size_t)j * D) = o0; *(v4u*)(dp + (size_t)j * D + 8) = o1; }
}
__device__ __forceinline__ void p0_copy_items(int lane, int first, int stride, int limit, const float* w_in, const float* w_out, bf16* Win_t, bf16* Wout_t) {
    if (first >= limit) return;
    f32x4 va[16], vb[16];
    TrItem ca = tr_item(first, w_in, w_out, Win_t, Wout_t), cb;
    tr_load(ca, va, lane);
#pragma unroll 1
    for (;;) {
        int nx = first + stride; const bool m1 = nx < limit;
        if (m1) { cb = tr_item(nx, w_in, w_out, Win_t, Wout_t); tr_load(cb, vb, lane); }
        tr_store(ca, va, lane);
        if (!m1) break;
        first = nx + stride; const bool m2 = first < limit;
        if (m2) { ca = tr_item(first, w_in, w_out, Win_t, Wout_t); tr_load(ca, va, lane); }
        tr_store(cb, vb, lane);
        if (!m2) break;
    }
}
constexpr int NCONV = 56;
struct CvItem { const float* W; int N, k0, n0, Kd; size_t drow0; float sc; unsigned char* dst; };
__device__ __forceinline__ CvItem cv_item(int it, const float* w_e_gate, const float* w_e_up, const float* w_e_down, unsigned char* Wgu8, unsigned char* Wd8) {
    CvItem c; const int pair = it >> 1, sub = it & 1, which = pair / (NE * 128), rr = pair % (NE * 128), e = rr >> 7, rem = rr & 127;
    if (which < 2) { const int nb = rem & 7, kb = (rem >> 3) * 2 + sub, n0 = nb * 64; c.W = (which ? w_e_up : w_e_gate) + (size_t)e * D * DE; c.N = DE; c.k0 = kb * 64; c.n0 = n0; c.Kd = D;
        c.drow0 = (size_t)e * 1024 + (n0 >> 7) * 256 + which * 128 + (n0 & 127); c.sc = S_WGU; c.dst = Wgu8; }
    else { const int nb = rem & 31, kb = (rem >> 5) * 2 + sub; c.W = w_e_down + (size_t)e * DE * D; c.N = D; c.k0 = kb * 64; c.n0 = nb * 64; c.Kd = DE; c.drow0 = (size_t)e * D + nb * 64; c.sc = S_WD; c.dst = Wd8; }
    return c;
}
__device__ __forceinline__ void cv_load(const CvItem& c, f32x4 (&v)[16], int lane) { const int lq = lane & 15, lk = lane >> 4;
#pragma unroll
    for (int i = 0; i < 16; ++i) v[i] = __builtin_nontemporal_load((const f32x4*)(c.W + (size_t)(c.k0 + 16 * lk + i) * c.N + c.n0 + 4 * lq)); }
__device__ __forceinline__ unsigned cv4(float a, float b, float cc, float d, float sc) {
    int p = __builtin_amdgcn_cvt_pk_fp8_f32(__builtin_amdgcn_fmed3f(a * sc, -448.f, 448.f), __builtin_amdgcn_fmed3f(b * sc, -448.f, 448.f), 0, false);
    p = __builtin_amdgcn_cvt_pk_fp8_f32(__builtin_amdgcn_fmed3f(cc * sc, -448.f, 448.f), __builtin_amdgcn_fmed3f(d * sc, -448.f, 448.f), p, true); return (unsigned)p; }
__device__ __forceinline__ void cv_store(const CvItem& c, const f32x4 (&v)[16], int lane) { const int lq = lane & 15, lk = lane >> 4;
    unsigned char* dp = c.dst + (c.drow0 + 4 * lq) * (size_t)c.Kd + c.k0 + 16 * lk;
#pragma unroll
    for (int j = 0; j < 4; ++j) { v4u o;
        o.x = cv4(v[0][j], v[1][j], v[2][j], v[3][j], c.sc); o.y = cv4(v[4][j], v[5][j], v[6][j], v[7][j], c.sc);
        o.z = cv4(v[8][j], v[9][j], v[10][j], v[11][j], c.sc); o.w = cv4(v[12][j], v[13][j], v[14][j], v[15][j], c.sc);
        __builtin_nontemporal_store(o, (v4u*)(dp + (size_t)j * c.Kd)); }
}
__device__ __forceinline__ void convert_experts(Frame& F, int cw, int ncw, const float* w_e_gate, const float* w_e_up, const float* w_e_down, unsigned char* Wgu8, unsigned char* Wd8) {
    constexpr int NPAIR = 3 * NE * 128;
    f32x4 va[16], vb[16];
    int pr = cw; if (pr >= NPAIR) return;
    CvItem ca = cv_item(2 * pr, w_e_gate, w_e_up, w_e_down, Wgu8, Wd8), cb;
    cv_load(ca, va, F.lane);
#pragma unroll 1
    for (;;) {
        cb = cv_item(2 * pr + 1, w_e_gate, w_e_up, w_e_down, Wgu8, Wd8); cv_load(cb, vb, F.lane);
        cv_store(ca, va, F.lane);
        const int nx = pr + ncw; const bool more = nx < NPAIR;
        if (more) { ca = cv_item(2 * nx, w_e_gate, w_e_up, w_e_down, Wgu8, Wd8); cv_load(ca, va, F.lane); }
        cv_store(cb, vb, F.lane);
        if (!more) break;
        pr = nx;
    }
}
__device__ __forceinline__ void p0_mod_unit(Frame& F, const float* c, const float* ada_w, const float* ada_b, float* mod, int unit) {
    const int n0 = unit * 64, lane = F.lane, w = F.wave, k0 = w * 256;
    LAS float* sc = (LAS float*)(F.lds + w * 16384);
    const GAS float* cp = (const GAS float*)c + k0 + lane; asm volatile("" : "+v"(cp));
#pragma unroll
    for (int b = 0; b < NB; ++b)
#pragma unroll
        for (int j = 0; j < 4; ++j) { const float v = cp[(size_t)b * D + 64 * j]; sc[(64 * j + lane) * 16 + b] = v * sigmoidf_(v); }
    LDS_WAIT(); asm volatile("" ::: "memory");
    float acc[NB][4];
#pragma unroll
    for (int b = 0; b < NB; ++b)
#pragma unroll
        for (int j = 0; j < 4; ++j) acc[b][j] = 0.f;
    const int lq = lane & 15, lk = lane >> 4;
    const GAS float* wp = (const GAS float*)ada_w + (size_t)(k0 + lk) * (6 * D) + n0 + 4 * lq;
    f32x4 wa[8];
#define P0_LOAD(u_, i0) wa[u_] = __builtin_nontemporal_load((const GAS f32x4*)(wp + (size_t)(4 * ((i0) + u_)) * (6 * D)))
#define P0_FMA(u_, i0) do { const LAS f32x4* sp = (const LAS f32x4*)(sc + (4 * ((i0) + u_) + lk) * 16); const f32x4 wv = wa[u_]; \
        _Pragma("unroll") for (int q = 0; q < 4; ++q) { const f32x4 s4 = sp[q]; \
            _Pragma("unroll") for (int bb = 0; bb < 4; ++bb) _Pragma("unroll") for (int j = 0; j < 4; ++j) acc[q * 4 + bb][j] += s4[bb] * wv[j]; } } while (0)
    asm volatile("" : "+v"(wp));
#pragma unroll
    for (int u = 0; u < 8; ++u) P0_LOAD(u, 0);
#pragma unroll 1
    for (int i0 = 0; i0 < 56; i0 += 8) {
        asm volatile("" : "+v"(wp));
#pragma unroll
        for (int u = 0; u < 8; ++u) { P0_FMA(u, i0); P0_LOAD(u, 8); __builtin_amdgcn_sched_barrier(0); }
        wp += (size_t)32 * (6 * D);
    }
#pragma unroll
    for (int u = 0; u < 8; ++u) { P0_FMA(u, 56); __builtin_amdgcn_sched_barrier(0); }
#undef P0_LOAD
#undef P0_FMA
    LDS_WAIT(); asm volatile("" ::: "memory");
    LAS f32x4* rp = (LAS f32x4*)(F.lds + w * 16384) + lane * 16;
#pragma unroll
    for (int b = 0; b < NB; ++b) rp[b] = (f32x4){acc[b][0], acc[b][1], acc[b][2], acc[b][3]};
    LDS_WAIT(); __syncthreads();
    for (int o = F.tid; o < NB * 64; o += NWAVES * 64) { const int b = o >> 6, n = o & 63, q = n >> 2, j = n & 3; float s = 0.f;
#pragma unroll
        for (int ww = 0; ww < 8; ++ww)
#pragma unroll
            for (int gq = 0; gq < 4; ++gq) s += ((const LAS float*)(F.lds + ww * 16384))[(gq * 16 + q) * 64 + b * 4 + j];
        mod[(size_t)b * (6 * D) + n0 + n] = s + ada_b[n0 + n]; }
    LDS_WAIT(); __syncthreads();
}

__device__ __forceinline__ void modnorm_rows(Frame& F, const float* xin, bf16* xn, const float* gain, const float* shift, const float* scale, int r0, int nrows) {
    int ln = F.lane; asm volatile("" : "+v"(ln));
    f32x4 mu[8], ad[8];
#pragma unroll
    for (int j = 0; j < 8; ++j) { const f32x4 g = ((const f32x4*)gain)[ln + 64 * j], sc = ((const f32x4*)scale)[ln + 64 * j]; mu[j] = g * (1.0f + sc); ad[j] = ((const f32x4*)shift)[ln + 64 * j]; }
    for (int r = r0; r < r0 + nrows; r += 2) {
        const f32x4* xr = (const f32x4*)(xin + (size_t)r * D) + ln;
        f32x4 v[2][8]; float s[2] = {0.f, 0.f};
#pragma unroll
        for (int q = 0; q < 2; ++q)
#pragma unroll
            for (int j = 0; j < 8; ++j) v[q][j] = __builtin_nontemporal_load(xr + q * (D / 4) + 64 * j);
#pragma unroll
        for (int q = 0; q < 2; ++q) {
#pragma unroll
            for (int j = 0; j < 8; ++j) s[q] += (v[q][j].x * v[q][j].x + v[q][j].y * v[q][j].y) + (v[q][j].z * v[q][j].z + v[q][j].w * v[q][j].w);
            const float rstd = fast_rsq(wave_sum(s[q]) * (1.0f / D) + EPS);
            v2u* o8 = (v2u*)(xn + (size_t)(r + q) * D) + ln;
#pragma unroll
            for (int j = 0; j < 8; ++j) { const f32x4 h = v[q][j] * rstd * mu[j] + ad[j]; v2u w; w.x = cvtpk(h.x, h.y); w.y = cvtpk(h.z, h.w); o8[64 * j] = w; }
        }
    }
}

__device__ __forceinline__ float gelu_tanh(float x) {
    const float t = 1.5957691216f * (x + 0.044715f * x * x * x);
    return x * sigmoidf_(t);
}
template <int CTRL> __device__ __forceinline__ float dpp_f(float old, float src) {
    return __builtin_bit_cast(float, __builtin_amdgcn_update_dpp(__builtin_bit_cast(int, old), __builtin_bit_cast(int, src), CTRL, 0xf, 0xf, false)); }
__device__ __forceinline__ float row16_sum(float v) {
    v += dpp_f<0xB1>(0.f, v);
    v += dpp_f<0x4E>(0.f, v);
    v += dpp_f<0x141>(0.f, v);
    v += dpp_f<0x140>(0.f, v);
    return v;
}
constexpr int MB_TB = 128, MB_PITCH = 272;
constexpr int MB_XI = 0, MB_C4 = 2 * MB_TB * MB_PITCH, MB_RING = MB_C4 + 5 * 128 * 4, MB_RPITCH = 144, MB_RB = MB_TB * MB_RPITCH;
constexpr int MB_SSW = MB_RING + 3 * MB_RB, MB_END = MB_SSW + 3 * 4 * MB_TB * 4;
static_assert(MB_END <= LDSCTL_OFF, "mixer LDS");
__device__ __forceinline__ void p3_unit(Frame& F, const bf16* proj, bf16* Y, float* PART, const float* conv3_w, const float* gconv, const float* conv4_w, const float* conv4_b, const float* lru_w_a, const float* lru_b_a,
                                        const float* lru_w_x, const float* lru_b_x, const float* lam, const float* glru, int unit) {
    const int b = unit >> 4, hd = (unit >> 1) & 7, half = unit & 1, lane = F.lane, w = F.wave, c = lane & 15, kg = lane >> 4;
    const bool isB = w < 4;
    LAS float* C4 = (LAS float*)(F.lds + MB_C4);
    __syncthreads();
    for (int idx = F.tid; idx < 5 * 128; idx += NWAVES * 64) { const int tap = idx >> 7, ch = idx & 127; C4[idx] = tap < 4 ? conv4_w[tap * DL + hd * 128 + ch] : conv4_b[hd * 128 + ch]; }
    const int pc = F.tid & 15, tg = F.tid >> 4;
    LAS unsigned char* xi_w = F.lds + MB_XI + (4 * tg) * MB_PITCH + pc * 16;
    LAS unsigned char* c4l = F.lds + MB_C4 + pc * 32;
    const bf16* xb = proj + (size_t)b * SEQ * DIN + 4 * 1024 + hd * 128 + pc * 8;
    const int cb = half * 64 + 16 * (w & 3), kx = cb >> 5;
    bf16x8 fa[4], fx[4], idn;
    float nba[4], nbx[4], nsp2[4], hfin[4];
    const bf16* gb = proj + (size_t)b * SEQ * DIN + 3 * 1024 + hd * 128 + 32 * kx + 8 * kg;
    LAS unsigned char* ring_w = F.lds + MB_RING + c * MB_RPITCH + (16 * (w & 3) + 4 * kg) * 2;
    LAS float* ssw_w = (LAS float*)(F.lds + MB_SSW) + (w & 3) * MB_TB + c;
    const int aw = w & 3;
#define P3_PUBLISH(blk) do { int la_ = lane, aw_ = aw; asm volatile("" : "+v"(la_), "+s"(aw_)); const LAS float* sw_ = (const LAS float*)(F.lds + MB_SSW) + ((blk) % 3) * 4 * MB_TB + 32 * aw_ + (la_ & 31); \
        const float own_ = (sw_[0] + sw_[MB_TB]) + (sw_[2 * MB_TB] + sw_[3 * MB_TB]); \
        if (la_ < 32) __hip_atomic_store(PART + ((size_t)unit * 16 + (blk)) * MB_TB + 32 * aw_ + la_, own_, RLX_AGENT); \
        asm volatile("s_waitcnt vmcnt(0)" ::: "memory"); \
        if (la_ == 0) __hip_atomic_store((unsigned*)(F.ctl + CW_FLG) + (unit * 16 + (blk)) * 4 + aw_, 1u, RLX_AGENT); } while (0)
#define P3_NORMALISE(blk) do { int la_ = lane, aw_ = aw; asm volatile("" : "+v"(la_), "+s"(aw_)); { unsigned* fo_ = (unsigned*)(F.ctl + CW_FLG) + ((unit ^ 1) * 16 + (blk)) * 4 + aw_; unsigned sp_ = 0; \
          while (__builtin_amdgcn_readfirstlane(__hip_atomic_load(fo_, RLX_AGENT)) == 0u) { if (++sp_ > (1u << 20)) break; __builtin_amdgcn_s_sleep(2); } } \
        const LAS float* sw_ = (const LAS float*)(F.lds + MB_SSW) + ((blk) % 3) * 4 * MB_TB + 32 * aw_ + (la_ & 31); \
        const float tot_ = ((sw_[0] + sw_[MB_TB]) + (sw_[2 * MB_TB] + sw_[3 * MB_TB])) + __hip_atomic_load(PART + ((size_t)(unit ^ 1) * 16 + (blk)) * MB_TB + 32 * aw_ + (la_ & 31), RLX_AGENT); \
        const float rs_ = fast_rsq(tot_ * (1.0f / LRU_HD) + EPS); \
        float gl8[8]; { const f32x4* gp_ = (const f32x4*)(glru + hd * 128 + half * 64 + (la_ & 7) * 8); const f32x4 ga_ = gp_[0], gb_ = gp_[1]; \
            gl8[0] = ga_.x; gl8[1] = ga_.y; gl8[2] = ga_.z; gl8[3] = ga_.w; gl8[4] = gb_.x; gl8[5] = gb_.y; gl8[6] = gb_.z; gl8[7] = gb_.w; } \
        bf16* ynorm = Y + (size_t)b * SEQ * D + DC + hd * 128 + half * 64 + (la_ & 7) * 8; \
        _Pragma("unroll") for (int i_ = 0; i_ < 4; ++i_) { const int tl_ = (la_ >> 3) + 8 * i_; const float r_ = __shfl(rs_, tl_); \
            const v4u p_ = *(const LAS v4u*)(F.lds + MB_RING + ((blk) % 3) * MB_RB + (32 * aw_ + tl_) * MB_RPITCH + (la_ & 7) * 16); \
            v4u o_; o_.x = cvtpk(bf_lo(p_.x) * r_ * gl8[0], bf_hi(p_.x) * r_ * gl8[1]); o_.y = cvtpk(bf_lo(p_.y) * r_ * gl8[2], bf_hi(p_.y) * r_ * gl8[3]); \
            o_.z = cvtpk(bf_lo(p_.z) * r_ * gl8[4], bf_hi(p_.z) * r_ * gl8[5]); o_.w = cvtpk(bf_lo(p_.w) * r_ * gl8[6], bf_hi(p_.w) * r_ * gl8[7]); \
            *(v4u*)(ynorm + (size_t)((blk) * MB_TB + 32 * aw_ + tl_) * D) = o_; } } while (0)
    LAS unsigned char* xi_r = F.lds + MB_XI + c * MB_PITCH + kg * 16;
    const int ach0 = (w & 1) * 512 + lane * 8, at0 = unit * 128 + ((w >> 1) & 1) * 64;
    float u1[8], u2[8];
    if (isB) {
#pragma unroll
        for (int ks = 0; ks < 4; ++ks) { float ta[8], tx[8];
#pragma unroll
            for (int j = 0; j < 8; ++j) { const size_t o = (size_t)hd * 16384 + (size_t)(32 * ks + 8 * kg + j) * 128 + cb + c; ta[j] = lru_w_a[o]; tx[j] = lru_w_x[o]; }
            v4u pa, px; pa.x = cvtpk(ta[0], ta[1]); pa.y = cvtpk(ta[2], ta[3]); pa.z = cvtpk(ta[4], ta[5]); pa.w = cvtpk(ta[6], ta[7]);
            px.x = cvtpk(tx[0], tx[1]); px.y = cvtpk(tx[2], tx[3]); px.z = cvtpk(tx[4], tx[5]); px.w = cvtpk(tx[6], tx[7]);
            fa[ks] = __builtin_bit_cast(bf16x8, pa); fx[ks] = __builtin_bit_cast(bf16x8, px); }
#pragma unroll
        for (int j = 0; j < 8; ++j) idn[j] = (8 * kg + j == (cb & 31) + c) ? (short)0x3f80 : (short)0;
#pragma unroll
        for (int r = 0; r < 4; ++r) { const int ch = hd * 128 + cb + 4 * kg + r; nba[r] = -1.44269504089f * lru_b_a[ch]; nbx[r] = -1.44269504089f * lru_b_x[ch];
            nsp2[r] = -8.0f * 1.44269504089f * log1pf(expf(-lam[ch])); hfin[r] = 0.f; }
    } else {
        v4u c1 = {0, 0, 0, 0}, x1 = {0, 0, 0, 0}, c2 = {0, 0, 0, 0}, x2 = {0, 0, 0, 0};
        if ((at0 % SEQ) != 0) { const bf16* p1 = proj + (size_t)(at0 - 1) * DIN + ach0; const bf16* p2 = proj + (size_t)(at0 - 2) * DIN + ach0;
            c1 = *(const v4u*)(p1 + DC); x1 = *(const v4u*)(p1 + 2 * DC); c2 = *(const v4u*)(p2 + DC); x2 = *(const v4u*)(p2 + 2 * DC); }
#pragma unroll
        for (int q = 0; q < 4; ++q) { u1[2 * q] = bf_lo(c1[q]) * bf_lo(x1[q]); u1[2 * q + 1] = bf_hi(c1[q]) * bf_hi(x1[q]); u2[2 * q] = bf_lo(c2[q]) * bf_lo(x2[q]); u2[2 * q + 1] = bf_hi(c2[q]) * bf_hi(x2[q]); }
    }
    asm volatile("" : "+v"(xi_w), "+v"(xi_r), "+v"(c4l));
    LDS_WAIT(); __syncthreads();
    v4u rows[7];
#pragma unroll
    for (int i = 0; i < 7; ++i) { const int tt = 4 * tg - 3 + i; rows[i] = (v4u){0, 0, 0, 0}; if (tt >= 0) rows[i] = *(const v4u*)(xb + (size_t)tt * DIN); }
    bf16x8 gq0 = {0, 0, 0, 0, 0, 0, 0, 0}, gq1 = gq0;
    if (isB) { gq0 = *(const bf16x8*)(gb + (size_t)c * DIN); gq1 = *(const bf16x8*)(gb + (size_t)(16 + c) * DIN); }
#pragma unroll 1
    for (int tb = 0; tb < SEQ / MB_TB; ++tb) {
        const int t0 = tb * MB_TB, bufo = (tb & 1) * (MB_TB * MB_PITCH);
        {
            float wt[4][8], bs[8];
#pragma unroll
            for (int tap = 0; tap < 4; ++tap) { const LAS f32x4* wp = (const LAS f32x4*)(c4l + tap * 512); const f32x4 wa = wp[0], wb = wp[1];
                wt[tap][0] = wa.x; wt[tap][1] = wa.y; wt[tap][2] = wa.z; wt[tap][3] = wa.w; wt[tap][4] = wb.x; wt[tap][5] = wb.y; wt[tap][6] = wb.z; wt[tap][7] = wb.w; }
            { const LAS f32x4* wp = (const LAS f32x4*)(c4l + 4 * 512); const f32x4 wa = wp[0], wb = wp[1]; bs[0] = wa.x; bs[1] = wa.y; bs[2] = wa.z; bs[3] = wa.w; bs[4] = wb.x; bs[5] = wb.y; bs[6] = wb.z; bs[7] = wb.w; }
#pragma unroll
            for (int i = 0; i < 4; ++i) { float xc[8];
#pragma unroll
                for (int j = 0; j < 8; ++j) xc[j] = bs[j];
#pragma unroll
                for (int tap = 0; tap < 4; ++tap) { const v4u v = rows[i + tap];
                    xc[0] += wt[tap][0] * bf_lo(v.x); xc[1] += wt[tap][1] * bf_hi(v.x); xc[2] += wt[tap][2] * bf_lo(v.y); xc[3] += wt[tap][3] * bf_hi(v.y);
                    xc[4] += wt[tap][4] * bf_lo(v.z); xc[5] += wt[tap][5] * bf_hi(v.z); xc[6] += wt[tap][6] * bf_lo(v.w); xc[7] += wt[tap][7] * bf_hi(v.w); }
                v4u p; p.x = cvtpk(xc[0], xc[1]); p.y = cvtpk(xc[2], xc[3]); p.z = cvtpk(xc[4], xc[5]); p.w = cvtpk(xc[6], xc[7]);
                *(LAS v4u*)(xi_w + bufo + i * MB_PITCH) = p; }
        }
        LDS_WAIT(); __syncthreads();
        if (tb + 1 < SEQ / MB_TB) {
#pragma unroll
            for (int i = 0; i < 7; ++i) rows[i] = *(const v4u*)(xb + (size_t)(t0 + MB_TB + 4 * tg - 3 + i) * DIN);
        }
        if (isB) {
#pragma unroll 1
            for (int s = 0; s < MB_TB / 16; ++s) {
                const bf16x8 gfr = gq0; gq0 = gq1;
                { int tn = t0 + 16 * (s + 2) + c; tn = tn < SEQ ? tn : SEQ - 1; gq1 = *(const bf16x8*)(gb + (size_t)tn * DIN); }
                f32x4 ar = {0.f, 0.f, 0.f, 0.f}, ai = ar, ax = ar, ag = ar;
                const LAS unsigned char* xr = xi_r + bufo + s * (16 * MB_PITCH);
#pragma unroll
                for (int ks = 0; ks < 4; ++ks) { const bf16x8 xf = *(const LAS bf16x8*)(xr + ks * 64);
                    ar = __builtin_amdgcn_mfma_f32_16x16x32_bf16(fa[ks], xf, ar, 0, 0, 0);
                    ai = __builtin_amdgcn_mfma_f32_16x16x32_bf16(fx[ks], xf, ai, 0, 0, 0); }
                { const bf16x8 xf = *(const LAS bf16x8*)(xr + kx * 64); ax = __builtin_amdgcn_mfma_f32_16x16x32_bf16(idn, xf, ax, 0, 0, 0); }
                ag = __builtin_amdgcn_mfma_f32_16x16x32_bf16(idn, gfr, ag, 0, 0, 0);
                float yv[4], Hs[4], Ps[4];
#pragma unroll
                for (int r = 0; r < 4; ++r) {
                    const float rg = fast_rcp(1.0f + __builtin_amdgcn_exp2f(ar[r] * -1.44269504089f + nba[r]));
                    const float ig = fast_rcp(1.0f + __builtin_amdgcn_exp2f(ai[r] * -1.44269504089f + nbx[r]));
                    const float la2 = nsp2[r] * rg;
                    const float a = __builtin_amdgcn_exp2f(la2), z = la2 * 1.38629436112f;
                    const float em1 = z * (1.0f + z * (0.5f + z * (0.16666667f + z * (0.041666668f + z * 0.0083333333f))));
                    const float om = (z > -0.35f) ? -em1 : 1.0f - a * a;
                    const float u = fast_sqrt(om) * ig * ax[r];
                    const float hp = dpp_f<0x121>(0.f, hfin[r]);
                    Hs[r] = (c == 0) ? a * hp + u : u; Ps[r] = a;
                }
#define SC_LVL(d) "v_fmac_f32_dpp %0, %0, %4 row_shr:" #d " row_mask:0xf bank_mask:0xf\n\tv_fmac_f32_dpp %1, %1, %5 row_shr:" #d " row_mask:0xf bank_mask:0xf\n\t" \
                  "v_fmac_f32_dpp %2, %2, %6 row_shr:" #d " row_mask:0xf bank_mask:0xf\n\tv_fmac_f32_dpp %3, %3, %7 row_shr:" #d " row_mask:0xf bank_mask:0xf\n\t"
#define SC_PRD(d) "v_mul_f32_dpp %4, %4, %4 row_shr:" #d " row_mask:0xf bank_mask:0xf\n\tv_mul_f32_dpp %5, %5, %5 row_shr:" #d " row_mask:0xf bank_mask:0xf\n\t" \
                  "v_mul_f32_dpp %6, %6, %6 row_shr:" #d " row_mask:0xf bank_mask:0xf\n\tv_mul_f32_dpp %7, %7, %7 row_shr:" #d " row_mask:0xf bank_mask:0xf\n\t"
                asm volatile("s_nop 1\n\t" SC_LVL(1) SC_PRD(1) SC_LVL(2) SC_PRD(2) SC_LVL(4) SC_PRD(4) SC_LVL(8) "s_nop 0"
                             : "+v"(Hs[0]), "+v"(Hs[1]), "+v"(Hs[2]), "+v"(Hs[3]), "+v"(Ps[0]), "+v"(Ps[1]), "+v"(Ps[2]), "+v"(Ps[3]));
#undef SC_LVL
#undef SC_PRD
#pragma unroll
                for (int r = 0; r < 4; ++r) { hfin[r] = Hs[r]; yv[r] = Hs[r] * gelu_tanh(ag[r]); }
                v2u o; o.x = cvtpk(yv[0], yv[1]); o.y = cvtpk(yv[2], yv[3]);
                *(LAS v2u*)(ring_w + (tb % 3) * MB_RB + s * (16 * MB_RPITCH)) = o;
                float q2 = (yv[0] * yv[0] + yv[1] * yv[1]) + (yv[2] * yv[2] + yv[3] * yv[3]);
                q2 += __shfl_xor(q2, 16); q2 += __shfl_xor(q2, 32);
                if (kg == 0) ssw_w[(tb % 3) * 4 * MB_TB + 16 * s] = q2;
            }
        } else {
            if (tb >= 1) P3_PUBLISH(tb - 1);
            if (tb >= 2) P3_NORMALISE(tb - 2);
            float w0[8], w1[8], w2[8], gg[8];
            { const f32x4* p0 = (const f32x4*)(conv3_w + ach0); const f32x4* p1 = (const f32x4*)(conv3_w + DC + ach0); const f32x4* p2 = (const f32x4*)(conv3_w + 2 * DC + ach0); const f32x4* pg = (const f32x4*)(gconv + ach0);
#pragma unroll
              for (int h = 0; h < 2; ++h) { const f32x4 a0 = p0[h], a1 = p1[h], a2 = p2[h], ag4 = pg[h];
#pragma unroll
                  for (int j = 0; j < 4; ++j) { w0[4 * h + j] = a0[j]; w1[4 * h + j] = a1[j]; w2[4 * h + j] = a2[j]; gg[4 * h + j] = ag4[j]; } } }
#pragma unroll
            for (int tt = 0; tt < 4; ++tt) { const int t = at0 + tb * 4 + tt;
                const bf16* p = proj + (size_t)t * DIN + ach0;
                const v4u bv = *(const v4u*)p, cv = *(const v4u*)(p + DC), xv = *(const v4u*)(p + 2 * DC);
                float y[8]; float ss = 0.f;
#pragma unroll
                for (int q = 0; q < 4; ++q) {
                    const float ua0 = bf_lo(cv[q]) * bf_lo(xv[q]), ub0 = bf_hi(cv[q]) * bf_hi(xv[q]);
                    const float va = w0[2 * q] * u2[2 * q] + w1[2 * q] * u1[2 * q] + w2[2 * q] * ua0;
                    const float vb = w0[2 * q + 1] * u2[2 * q + 1] + w1[2 * q + 1] * u1[2 * q + 1] + w2[2 * q + 1] * ub0;
                    u2[2 * q] = u1[2 * q]; u1[2 * q] = ua0; u2[2 * q + 1] = u1[2 * q + 1]; u1[2 * q + 1] = ub0;
                    y[2 * q] = bf_lo(bv[q]) * va; y[2 * q + 1] = bf_hi(bv[q]) * vb;
                    ss += y[2 * q] * y[2 * q] + y[2 * q + 1] * y[2 * q + 1];
                }
                ss += dpp_f<0xB1>(0.f, ss); ss += dpp_f<0x4E>(0.f, ss); ss += dpp_f<0x141>(0.f, ss);
                const float rstd = fast_rsq(ss * (1.0f / CONV_HD) + EPS);
                v4u o;
#pragma unroll
                for (int q = 0; q < 4; ++q) o[q] = cvtpk(y[2 * q] * rstd * gg[2 * q], y[2 * q + 1] * rstd * gg[2 * q + 1]);
                *(v4u*)(Y + (size_t)t * D + ach0) = o;
            }
        }
    }
    LDS_WAIT(); __syncthreads();
    if (!isB) { P3_PUBLISH(SEQ / MB_TB - 1); P3_NORMALISE(SEQ / MB_TB - 2); P3_NORMALISE(SEQ / MB_TB - 1); }
#undef P3_PUBLISH
#undef P3_NORMALISE
    __syncthreads();
}
__device__ __forceinline__ void p3b_rows(Frame& F, const bf16* YRAW, bf16* Y, const float* glru, int r0, int nrows) {
    float g[2][8];
#pragma unroll
    for (int i = 0; i < 2; ++i)
#pragma unroll
        for (int j = 0; j < 8; ++j) g[i][j] = glru[(F.lane + 64 * i) * 8 + j];
#pragma unroll 4
    for (int r = r0; r < r0 + nrows; ++r) { v4u* yr = (v4u*)(Y + (size_t)r * D + DC) + F.lane; const v4u* ys = (const v4u*)(YRAW + (size_t)r * DL) + F.lane;
#pragma unroll
        for (int i = 0; i < 2; ++i) { const v4u p = ys[64 * i];
            float v[8] = {bf_lo(p.x), bf_hi(p.x), bf_lo(p.y), bf_hi(p.y), bf_lo(p.z), bf_hi(p.z), bf_lo(p.w), bf_hi(p.w)};
            float ss = 0.f;
#pragma unroll
            for (int j = 0; j < 8; ++j) ss += v[j] * v[j];
            const float rstd = fast_rsq(row16_sum(ss) * (1.0f / LRU_HD) + EPS);
            v4u o; o.x = cvtpk(v[0] * rstd * g[i][0], v[1] * rstd * g[i][1]); o.y = cvtpk(v[2] * rstd * g[i][2], v[3] * rstd * g[i][3]);
            o.z = cvtpk(v[4] * rstd * g[i][4], v[5] * rstd * g[i][5]); o.w = cvtpk(v[6] * rstd * g[i][6], v[7] * rstd * g[i][7]);
            yr[64 * i] = o; } }
}

constexpr int P5_ROWB = 4112, P5_SLOT = 16, P5_IMG = P5_SLOT * P5_ROWB;
constexpr int P5_PSB = 4 * P5_SLOT * NRC * 4;
constexpr int P5_DEC_OFF = 2 * P5_IMG;
static_assert(P5_DEC_OFF + 4096 <= LDSCTL_OFF && P5_PSB + P5_SLOT * 72 * 4 <= P5_IMG, "P5 LDS");
#define P5_BAR() do { asm volatile("s_waitcnt lgkmcnt(0)" ::: "memory"); __builtin_amdgcn_s_barrier(); asm volatile("" ::: "memory"); } while (0)
struct P5Row { v2u m[8]; };
__device__ __forceinline__ void p5_issue(P5Row& R, const bf16* x1b, int r, int lane) {
    const v2u* mr = (const v2u*)(x1b + (size_t)r * D) + lane;
#pragma unroll
    for (int j = 0; j < 8; ++j) R.m[j] = mr[64 * j];
}
__device__ __forceinline__ void p5_row(const P5Row& R, const f32x4 (&mu)[8], const f32x4 (&ad)[8], unsigned char* xn, int r, LAS unsigned char* img_row, int lane) {
    f32x4 xv[8]; float s = 0.f;
#pragma unroll
    for (int j = 0; j < 8; ++j) { const v2u m2 = R.m[j];
        xv[j] = (f32x4){bf_lo(m2.x), bf_hi(m2.x), bf_lo(m2.y), bf_hi(m2.y)}; s += (xv[j].x * xv[j].x + xv[j].y * xv[j].y) + (xv[j].z * xv[j].z + xv[j].w * xv[j].w); }
    s = row16_sum(s);
    { const int si = __builtin_bit_cast(int, s);
      s = (__builtin_bit_cast(float, __builtin_amdgcn_readlane(si, 0)) + __builtin_bit_cast(float, __builtin_amdgcn_readlane(si, 16))) + (__builtin_bit_cast(float, __builtin_amdgcn_readlane(si, 32)) + __builtin_bit_cast(float, __builtin_amdgcn_readlane(si, 48))); }
    const float rstd = fast_rsq(s * (1.0f / D) + EPS);
    unsigned* o8 = (unsigned*)(xn + (size_t)r * D) + lane;
#pragma unroll
    for (int j = 0; j < 8; ++j) {
        const f32x4 h = xv[j] * rstd * mu[j] + ad[j]; v2u hi; hi.x = cvtpk(h.x, h.y); hi.y = cvtpk(h.z, h.w);
        o8[64 * j] = cvt4_fp8(h.x, h.y, h.z, h.w);
        *(LAS v2u*)(img_row + (lane + 64 * j) * 8) = hi; }
}
__device__ __forceinline__ void p5_group(Frame& F, const float* mb, const float* norm2_g, unsigned char* xn, const bf16* x1b, const bf16* wr_hi,
                                         const float* rbg, const float* rbe, int row0, int* ltok, float* lwt) {
    int lane = F.lane; asm volatile("" : "+v"(lane));
    const int w = F.wave; constexpr int NSL = 128 / P5_SLOT;
    LAS int* DEC_E = (LAS int*)(F.lds + P5_DEC_OFF); LAS float* DEC_W = (LAS float*)(F.lds + P5_DEC_OFF + 1024); LAS int* DEC_LP = (LAS int*)(F.lds + P5_DEC_OFF + 2048);
    LAS unsigned* LCNT = (LAS unsigned*)(F.lds + P5_DEC_OFF + 3072); LAS unsigned* GBASE = (LAS unsigned*)(F.lds + P5_DEC_OFF + 3328);
    LAS float* RBE = (LAS float*)(F.lds + P5_DEC_OFF + 3584); LAS float* RBG = (LAS float*)(F.lds + P5_DEC_OFF + 3840);
    int tid = F.tid; asm volatile("" : "+v"(tid));
    if (tid < 64) { LCNT[tid] = 0u; RBE[tid] = rbe[tid]; if (tid < 8) RBG[tid] = rbg[tid]; }
    LDS_WAIT(); __syncthreads();
    if (w < 4) {
        f32x4 mu[8], ad[8];
        { const GAS f32x4* pg = (const GAS f32x4*)norm2_g + lane; const GAS f32x4* pm = (const GAS f32x4*)mb + lane;
#pragma unroll
          for (int j = 0; j < 8; ++j) { if (j == 4) asm volatile("" : "+v"(pg), "+v"(pm));
              const f32x4 g = pg[64 * j], sc = pm[4 * (D / 4) + 64 * j]; mu[j] = g * (1.0f + sc); ad[j] = pm[3 * (D / 4) + 64 * j]; } }
        P5Row R0, R1, R2, R3;
        { const int r = row0 + 4 * w; p5_issue(R0, x1b, r, lane); p5_issue(R1, x1b, r + 1, lane); p5_issue(R2, x1b, r + 2, lane); p5_issue(R3, x1b, r + 3, lane); }
#pragma unroll 1
        for (int sl = 0; sl < NSL; ++sl) {
            LAS unsigned char* ibw = F.lds + (sl & 1) * P5_IMG + (4 * w) * P5_ROWB;
            const int rb = row0 + sl * P5_SLOT + 4 * w, nrb = sl + 1 < NSL ? rb + P5_SLOT : rb;
            p5_row(R0, mu, ad, xn, rb, ibw, lane); p5_issue(R0, x1b, nrb, lane);
            p5_row(R1, mu, ad, xn, rb + 1, ibw + P5_ROWB, lane); p5_issue(R1, x1b, nrb + 1, lane);
            P5_BAR();
            p5_row(R2, mu, ad, xn, rb + 2, ibw + 2 * P5_ROWB, lane); p5_issue(R2, x1b, nrb + 2, lane);
            P5_BAR();
            p5_row(R3, mu, ad, xn, rb + 3, ibw + 3 * P5_ROWB, lane); p5_issue(R3, x1b, nrb + 3, lane);
            P5_BAR();
        }
        P5_BAR(); P5_BAR(); P5_BAR();
    } else {
        const int cw = w & 3, fr = lane & 15, fq = lane >> 4;
        f32x4 acc[5];
        const GAS char* wbs = (const GAS char*)wr_hi + (size_t)cw * (5 * 16 * 1024); const unsigned lo16 = (unsigned)lane * 16u;
        bf16x8 bres[16][2];
        { const GAS char* wq = wbs; asm volatile("" : "+s"(wq));
#pragma unroll
          for (int ks = 0; ks < 16; ++ks) { bres[ks][0] = *(const GAS bf16x8*)(wq + ks * 1024 + lo16); bres[ks][1] = *(const GAS bf16x8*)(wq + (16 + ks) * 1024 + lo16); } }
        bf16x8 bw[12];
#define P5_BPTR(p_) (wq + (16 * (2 + (p_) % 3) + (p_) / 3) * 1024 + lo16)
        { const GAS char* wq = wbs; asm volatile("" : "+s"(wq));
#pragma unroll
          for (int p = 0; p < 12; ++p) bw[p] = *(const GAS bf16x8*)P5_BPTR(p); }
        P5_BAR(); P5_BAR(); P5_BAR();
#pragma unroll 1
        for (int sl = 1; sl <= NSL; ++sl) {
            LAS unsigned char* ibr = F.lds + ((sl + 1) & 1) * P5_IMG;
            {
#pragma unroll
                for (int t = 0; t < 5; ++t) acc[t] = (f32x4){0.f, 0.f, 0.f, 0.f};
                const GAS char* wq = wbs;
                const LAS unsigned char* ap = ibr + fr * P5_ROWB + (cw * 512 + 8 * fq) * 2;
                asm volatile("" : "+s"(wq), "+v"(ap));
                bf16x8 av[2]; av[0] = *(const LAS bf16x8*)ap;
#pragma unroll
                for (int ks = 0; ks < 16; ++ks) {
                    if (ks + 1 < 16) av[(ks + 1) & 1] = *(const LAS bf16x8*)(ap + (ks + 1) * 64);
                    const bf16x8 a0 = av[ks & 1];
                    acc[0] = __builtin_amdgcn_mfma_f32_16x16x32_bf16(a0, bres[ks][0], acc[0], 0, 0, 0);
                    acc[1] = __builtin_amdgcn_mfma_f32_16x16x32_bf16(a0, bres[ks][1], acc[1], 0, 0, 0);
#pragma unroll
                    for (int t3 = 0; t3 < 3; ++t3) { const int p = ks * 3 + t3;
                        acc[2 + t3] = __builtin_amdgcn_mfma_f32_16x16x32_bf16(a0, bw[p % 12], acc[2 + t3], 0, 0, 0);
                        bw[p % 12] = *(const GAS bf16x8*)P5_BPTR((p + 12) % 48); }
                    __builtin_amdgcn_sched_barrier(0); }
            }
            P5_BAR();
            { LAS float* PS = (LAS float*)ibr;
#pragma unroll
                for (int t = 0; t < 5; ++t)
#pragma unroll
                    for (int j = 0; j < 4; ++j) PS[(cw * P5_SLOT + fq * 4 + j) * NRC + t * 16 + fr] = acc[t][j]; }
            P5_BAR();
            if (cw == 0 && lane < P5_SLOT) { const LAS float* PS = (const LAS float*)ibr; const int lr = lane;
                f32x4 ga = {0.f, 0.f, 0.f, 0.f}, gb = ga;
#pragma unroll
                for (int ww = 0; ww < 4; ++ww) { const LAS f32x4* q = (const LAS f32x4*)(PS + (ww * P5_SLOT + lr) * NRC); ga += q[0]; gb += q[1]; }
                float gl_[8] = {ga.x, ga.y, ga.z, ga.w, gb.x, gb.y, gb.z, gb.w}; float mx = -3.0e38f; int gi = 0;
#pragma unroll
                for (int c = 0; c < 8; ++c) { gl_[c] += RBG[c]; if (gl_[c] > mx) { mx = gl_[c]; gi = c; } }
                float den = 0.f;
#pragma unroll
                for (int c = 0; c < 8; ++c) den += fast_exp(gl_[c] - mx);
                const float pg = fast_rcp(den);
                f32x4 ea = {0.f, 0.f, 0.f, 0.f}, eb = ea;
#pragma unroll
                for (int ww = 0; ww < 4; ++ww) { const LAS f32x4* q = (const LAS f32x4*)(PS + (ww * P5_SLOT + lr) * NRC + 8 + gi * 8); ea += q[0]; eb += q[1]; }
                const f32x4 ra = *(const LAS f32x4*)(RBE + gi * 8), rb4 = *(const LAS f32x4*)(RBE + gi * 8 + 4);
                const float le_[8] = {ea.x + ra.x, ea.y + ra.y, ea.z + ra.z, ea.w + ra.w, eb.x + rb4.x, eb.y + rb4.y, eb.z + rb4.z, eb.w + rb4.w};
                float v0 = -3.0e38f, v1 = -3.0e38f; int i0 = 0, i1 = 0;
#pragma unroll
                for (int e = 0; e < 8; ++e) { const float le = le_[e]; const bool b0 = le > v0, b1 = le > v1;
                    v1 = b0 ? v0 : (b1 ? le : v1); i1 = b0 ? i0 : (b1 ? e : i1); v0 = b0 ? le : v0; i0 = b0 ? e : i0; }
                const float ex = fast_exp(v1 - v0), rq = fast_rcp(1.0f + ex), w0 = pg * rq, w1 = pg * ex * rq;
                const int e0 = gi * 8 + i0, e1 = gi * 8 + i1, di = 2 * ((sl - 1) * P5_SLOT + lr);
                DEC_LP[di] = (int)__hip_atomic_fetch_add(LCNT + e0, 1u, __ATOMIC_RELAXED, __HIP_MEMORY_SCOPE_WORKGROUP); DEC_LP[di + 1] = (int)__hip_atomic_fetch_add(LCNT + e1, 1u, __ATOMIC_RELAXED, __HIP_MEMORY_SCOPE_WORKGROUP);
                DEC_E[di] = e0; DEC_E[di + 1] = e1; DEC_W[di] = w0; DEC_W[di + 1] = w1;
            }
            P5_BAR();
        }
    }
    asm volatile("" : "+v"(tid));
    if (tid < 64) { const unsigned c = LCNT[tid]; unsigned base = 0u; if (c) base = __hip_atomic_fetch_add((unsigned*)(F.ctl + CW_CNT + 64 * tid), c, RLX_AGENT); GBASE[tid] = base; }
    LDS_WAIT(); __syncthreads();
    if (tid < 256) { const int e = DEC_E[tid]; const size_t pos = (size_t)e * LISTCAP + GBASE[e] + (unsigned)DEC_LP[tid];
        ltok[pos] = 2 * (row0 + (tid >> 1)) + (tid & 1); lwt[pos] = DEC_W[tid]; }
}

__device__ __forceinline__ void build_tables(Frame& F) {
    LAS int* tstart = (LAS int*)(F.lds + TAB_OFF); LAS int* texp = tstart + 80;
    __syncthreads();
    if (F.tid < 64) {
        const unsigned c = __hip_atomic_load((unsigned*)(F.ctl + CW_CNT + 64 * F.tid), RLX_AGENT);
        int tl = (int)((c + 255u) >> 8), incl = tl;
#pragma unroll
        for (int o = 1; o < 64; o <<= 1) { const int t = __shfl_up(incl, o); if (F.lane >= o) incl += t; }
        tstart[F.tid + 1] = incl; if (F.tid == 0) tstart[0] = 0; tstart[80 + MT_MAX + F.tid] = (int)c;
    }
    LDS_WAIT(); __syncthreads();
    for (int mt = F.tid; mt < MT_MAX; mt += NWAVES * 64) { int e = 0;
        for (int j = 1; j < NE; ++j) e += (tstart[j] <= mt) ? 1 : 0;
        texp[mt] = e; }
    LDS_WAIT(); __syncthreads();
}

constexpr int N_PHASES = 10;
__global__ void __launch_bounds__(NWAVES * 64, 2) hybrid_fwd(Args args) {
    extern __shared__ __attribute__((aligned(16))) unsigned char lds[];
    Frame F;
    F.lds = (LAS unsigned char*)lds;
    F.MISC = (volatile LAS unsigned*)(F.lds + MISC_OFF);
    F.tid = threadIdx.x; F.lane = F.tid & 63; F.wave = __builtin_amdgcn_readfirstlane(F.tid >> 6);
    F.G = gridDim.x; { const int bx = blockIdx.x; F.vcu = (F.G % 8 == 0) ? (bx % 8) * (F.G / 8) + bx / 8 : bx; }
    unsigned char* ws = args.ws;
    F.ctl = (gu32*)(ws + WS_CTL);
    const float* x = args.in[0]; const float* cvec = args.in[1]; const float* ada_w = args.in[2]; const float* ada_b = args.in[3]; const float* norm1_g = args.in[4];
    const float* w_in = args.in[5]; const float* conv3_w = args.in[6]; const float* conv4_w = args.in[7]; const float* conv4_b = args.in[8];
    const float* lru_w_a = args.in[9]; const float* lru_b_a = args.in[10]; const float* lru_w_x = args.in[11]; const float* lru_b_x = args.in[12]; const float* lru_lambda = args.in[13];
    const float* hn_conv_g = args.in[14]; const float* hn_lru_g = args.in[15]; const float* w_out = args.in[16]; const float* norm2_g = args.in[17];
    const float* rwg = args.in[18]; const float* rbg = args.in[19]; const float* rwe = args.in[20]; const float* rbe = args.in[21];
    const float* w_e_gate = args.in[22]; const float* w_e_up = args.in[23]; const float* w_e_down = args.in[24]; const float* final_g = args.in[25];
    float* out = args.out;
    float* mod = (float*)(ws + WS_MOD);
    bf16* wr_hi = (bf16*)(ws + WS_WR);
    int* ltok = (int*)(ws + WS_LTOK); float* lwt = (float*)(ws + WS_LW);
    bf16* Win_t = (bf16*)(ws + WS_WIN); bf16* Wout_t = (bf16*)(ws + WS_WOUT); unsigned char* Wgu8 = ws + WS_WGU; unsigned char* Wd8 = ws + WS_WD;
    bf16* XN = (bf16*)(ws + WS_XN); bf16* PROJ = (bf16*)(ws + WS_PROJ); bf16* YE = (bf16*)(ws + WS_PROJ); bf16* Y = (bf16*)(ws + WS_Y); unsigned char* HB = ws + WS_Y; bf16* MIX = (bf16*)(ws + WS_MIX); bf16* X1B = (bf16*)(ws + WS_X1B); bf16* YRAW = (bf16*)(ws + WS_XN);

    for (int u = F.tid; u < (LDS_BYTES - LDSCTL_OFF) / 4; u += NWAVES * 64) ((LAS unsigned*)(F.lds + LDSCTL_OFF))[u] = 0u;
    __syncthreads();
    XcdBarrier bar; bar.bar = (unsigned*)(F.ctl + CW_BAR); bar.x = 0; bar.st = nullptr;
    if (MK_N_LAUNCHES == 1) bar = xcd_barrier_post((unsigned*)(F.ctl + CW_BAR), F.MISC + 8);
    const int lo = args.ph_lo, hi = args.ph_hi;
#ifndef PHASE_MASK
#define PHASE_MASK 0x3ff
#endif
#define IN(k) (((PHASE_MASK >> (k)) & 1) && lo <= (k) && (k) < hi)
#define SEAM(k) do { if (IN(k) && IN((k) + 1)) xcd_barrier(bar); } while (0)
    const int gw = F.vcu * NWAVES + F.wave, NGW = F.G * NWAVES;

    if (IN(0)) {
        for (int u = blockIdx.x; u < (6 * D) / 64; u += F.G) p0_mod_unit(F, cvec, ada_w, ada_b, mod, u);
        for (int idx = blockIdx.x * (NWAVES * 64) + F.tid; idx < NRC * D; idx += F.G * NWAVES * 64) {
            const int j = idx & 7, ln = (idx >> 3) & 63, ks = (idx >> 9) & 15, ct = idx >> 13, t = ct % 5, cwk = ct / 5;
            const int n = 16 * t + (ln & 15), k = 512 * cwk + 32 * ks + 8 * (ln >> 4) + j;
            const float v = n < 8 ? rwg[k * 8 + n] : (n < 72 ? rwe[(size_t)((n - 8) >> 3) * D * 8 + k * 8 + ((n - 8) & 7)] : 0.f);
            wr_hi[idx] = (bf16)(cvtpk(v, 0.f) & 0xffffu); }
        constexpr int NMODU = (6 * D) / 64;
        if (F.G > NMODU + 8) {
            if ((int)blockIdx.x >= NMODU) p0_copy_items(F.lane, ((int)blockIdx.x - NMODU) * NWAVES + F.wave, (F.G - NMODU) * NWAVES, P0_SPARE_ITEMS, w_in, w_out, Win_t, Wout_t);
            else p0_copy_items(F.lane, P0_SPARE_ITEMS + (int)blockIdx.x * NWAVES + F.wave, NMODU * NWAVES, P0_NITEMS, w_in, w_out, Win_t, Wout_t);
        } else p0_copy_items(F.lane, gw, NGW, P0_NITEMS, w_in, w_out, Win_t, Wout_t);
    }
    SEAM(0);
    if (IN(1)) {
        for (int grp = gw; grp < M / 16; grp += NGW) { const int r0 = grp * 16, b = r0 / SEQ; const float* mb = mod + (size_t)b * (6 * D);
            modnorm_rows(F, x, XN, norm1_g, mb, mb + D, r0, 16); }
    }
    SEAM(1);
    if (IN(2)) {
        if (F.G > 2 * NCONV && (int)blockIdx.x < NCONV) convert_experts(F, (int)blockIdx.x * NWAVES + F.wave, NCONV * NWAVES, w_e_gate, w_e_up, w_e_down, Wgu8, Wd8);
        else { const bool split = F.G > 2 * NCONV;
            if (!split) convert_experts(F, gw, NGW, w_e_gate, w_e_up, w_e_down, Wgu8, Wd8);
            pg8::Gemm g{XN, Win_t, 2 * D}; pg8::StaticOrder S; S.init(M, DIN, split ? F.G - NCONV : F.G, split ? (int)blockIdx.x - NCONV : (int)blockIdx.x);
            pg8::EpiBf16 E{PROJ, DIN};
            pg8::gemm_phase<pg8::EpiBf16, pg8::StaticOrder, true>(F.lds, g, S, E); }
    }
    SEAM(2);
    if (IN(3)) {
        for (int u = blockIdx.x; u < 256; u += F.G) p3_unit(F, PROJ, Y, (float*)(ws + WS_PART), conv3_w, hn_conv_g, conv4_w, conv4_b, lru_w_a, lru_b_a, lru_w_x, lru_b_x, lru_lambda, hn_lru_g, u);
    }
    SEAM(3);
    if (IN(5)) {
        pg8::Gemm g{Y, Wout_t, 2 * D}; pg8::StaticOrder S; S.init(M, D, F.G, (int)blockIdx.x);
        pg8::EpiResid E{X1B, x, mod};
        pg8::gemm_phase<pg8::EpiResid, pg8::StaticOrder, true>(F.lds, g, S, E);
    }
    SEAM(5);
    if (IN(6)) {
        for (int grp = blockIdx.x; grp < M / 128; grp += F.G) { const int b = (grp * 128) / SEQ; const float* mb = mod + (size_t)b * (6 * D);
            p5_group(F, mb, norm2_g, (unsigned char*)XN, X1B, wr_hi, rbg, rbe, grp * 128, ltok, lwt);
            __syncthreads();
        }
    }
    SEAM(6);
    if (IN(7)) {
        build_tables(F);
        pg8::Gemm g{XN, Wgu8, D};
        pg8::GroupedOrder<4, true> S{(const LAS int*)(F.lds + TAB_OFF), (const LAS int*)(F.lds + TAB_OFF) + 80, ltok, (const unsigned*)(F.ctl + CW_CNT), F.G, F.vcu};
        pg8::EpiSwiGLU E{HB, lwt};
        pg8::gemm_phase<pg8::EpiSwiGLU, pg8::GroupedOrder<4, true>, true, true>(F.lds, g, S, E);
    }
    SEAM(7);
    if (IN(8)) {
        build_tables(F);
        pg8::Gemm g{HB, Wd8, DE};
        pg8::GroupedOrder<8, false> S{(const LAS int*)(F.lds + TAB_OFF), (const LAS int*)(F.lds + TAB_OFF) + 80, ltok, (const unsigned*)(F.ctl + CW_CNT), F.G, F.vcu};
        pg8::EpiF8G E{(unsigned char*)YE, ltok};
        pg8::gemm_phase<pg8::EpiF8G, pg8::GroupedOrder<8, false>, true, true>(F.lds, g, S, E);
    }
    SEAM(8);
    if (IN(9)) {
        int ln = F.lane; asm volatile("" : "+v"(ln));
        const unsigned char* YE8 = (const unsigned char*)YE;
        for (int grp = gw; grp < M / 16; grp += NGW) { const int r0 = grp * 16, b = r0 / SEQ; const float* g2 = mod + (size_t)b * (6 * D) + 5 * D;
            f32x4 gg[8], fg[8];
#pragma unroll
            for (int j = 0; j < 8; ++j) { gg[j] = ((const f32x4*)g2)[ln + 64 * j] * (1.0f / S_Y); fg[j] = ((const f32x4*)final_g)[ln + 64 * j]; }
            for (int r = r0; r < r0 + 16; ++r) {
                const unsigned* y0 = (const unsigned*)(YE8 + (size_t)(2 * r) * D) + ln; const unsigned* y1 = y0 + D / 4;
                f32x4* xr = (f32x4*)(out + (size_t)r * D) + ln; const v2u* x1r = (const v2u*)(X1B + (size_t)r * D) + ln;
                f32x4 v[8]; float s = 0.f;
#pragma unroll
                for (int j = 0; j < 8; ++j) { const unsigned a = y0[64 * j], c = y1[64 * j]; const v2u xb = x1r[64 * j];
                    const f32x2 a0 = __builtin_amdgcn_cvt_pk_f32_fp8((int)a, false), a1 = __builtin_amdgcn_cvt_pk_f32_fp8((int)a, true), c0 = __builtin_amdgcn_cvt_pk_f32_fp8((int)c, false), c1 = __builtin_amdgcn_cvt_pk_f32_fp8((int)c, true);
                    const f32x4 xv = {bf_lo(xb.x), bf_hi(xb.x), bf_lo(xb.y), bf_hi(xb.y)};
                    const f32x4 ys = {a0.x + c0.x, a0.y + c0.y, a1.x + c1.x, a1.y + c1.y};
                    v[j] = xv + gg[j] * ys; s += (v[j].x * v[j].x + v[j].y * v[j].y) + (v[j].z * v[j].z + v[j].w * v[j].w); }
                const float rstd = fast_rsq(wave_sum(s) * (1.0f / D) + EPS);
#pragma unroll
                for (int j = 0; j < 8; ++j) xr[64 * j] = v[j] * rstd * fg[j];
            }
        }
    }
#undef IN
#undef SEAM
}

extern "C" void kernel_launch(void* const* d_in, const int* in_sizes, int n_in, void* d_out, int out_size, void* d_ws, size_t ws_size, hipStream_t stream) {
    static int grid = 0;
    if (grid == 0) {
        if (n_in != 26 || in_sizes[0] != M * D || out_size != M * D || ws_size < WS_END) { fprintf(stderr, "kernel_launch: unexpected shapes (n_in %d, in0 %d, out %d, ws %zu < %zu); nothing launched\n", n_in, n_in > 0 ? in_sizes[0] : -1, out_size, ws_size, (size_t)WS_END); grid = -1; return; }
        int dev = 0, cus = 0, per_cu = 0;
        if (hipGetDevice(&dev) != hipSuccess || hipDeviceGetAttribute(&cus, hipDeviceAttributeMultiprocessorCount, dev) != hipSuccess) { fprintf(stderr, "kernel_launch: device query failed\n"); grid = -1; return; }
        if (hipFuncSetAttribute((const void*)hybrid_fwd, hipFuncAttributeMaxDynamicSharedMemorySize, LDS_BYTES) != hipSuccess) { fprintf(stderr, "kernel_launch: hipFuncSetAttribute failed\n"); grid = -1; return; }
        if (hipOccupancyMaxActiveBlocksPerMultiprocessor(&per_cu, (const void*)hybrid_fwd, NWAVES * 64, LDS_BYTES) != hipSuccess || per_cu < 1) { fprintf(stderr, "kernel_launch: occupancy query reports %d workgroups per CU\n", per_cu); }
        (void)hipGetLastError();
        grid = cus;
        if (grid % 8 != 0 || grid < 8) { fprintf(stderr, "kernel_launch: grid %d not a multiple of 8\n", grid); grid = -1; return; }
    }
    if (grid < 0) return;
    if (hipMemsetAsync((char*)d_ws + WS_CTL, 0, CTL_ZERO_BYTES, stream) != hipSuccess) { fprintf(stderr, "kernel_launch: memset failed\n"); return; }
    Args a{};
    for (int i = 0; i < 26; ++i) a.in[i] = (const float*)d_in[i];
    a.out = (float*)d_out; a.ws = (unsigned char*)d_ws;
    for (int li = 0; li < (MK_N_LAUNCHES == 1 ? 1 : N_PHASES); ++li) {
        a.ph_lo = (MK_N_LAUNCHES == 1) ? 0 : li; a.ph_hi = (MK_N_LAUNCHES == 1) ? N_PHASES : li + 1;
        hipLaunchKernelGGL(hybrid_fwd, dim3(grid), dim3(NWAVES * 64), LDS_BYTES, stream, a);
        const hipError_t le = hipPeekAtLastError();
        if (le != hipSuccess) { fprintf(stderr, "kernel_launch: launch %d failed: %s\n", li, hipGetErrorName(le)); break; }
    }
}
```

```cpp
#include <hip/hip_runtime.h>
#include <cstdio>
#include <cstdint>

#ifndef MK_N_LAUNCHES
#define MK_N_LAUNCHES 1
#endif

constexpr int D = 2048, NB = 16, SEQ = 2048, M = NB * SEQ;
constexpr int DC = 1024, DL = 1024, DIN = 5120;
constexpr int CONV_HD = 64, LRU_HEADS = 8, LRU_HD = 128;
constexpr int NE = 64, NGRP = 8, EPG = 8, DE = 512;
constexpr int NRC = 80;
constexpr float EPS = 1e-6f;
constexpr int MT_MAX = (2 * M) / 256 + NE;
constexpr int LISTCAP = M;
constexpr float S_WGU = 32.f, S_WD = 16.f, S_H = 16.f, S_Y = 64.f;

constexpr size_t MiB = 1u << 20;
constexpr size_t WS_CTL = 0, CTL_ZERO_BYTES = 1 * MiB;
constexpr size_t WS_MOD = 1 * MiB;
constexpr size_t WS_ROUT = 2 * MiB;
constexpr size_t WS_WR = 3 * MiB;
constexpr size_t WS_LTOK = 4 * MiB;
constexpr size_t WS_LW = 12 * MiB;
constexpr size_t WS_WIN = 20 * MiB;
constexpr size_t WS_WOUT = 40 * MiB;
constexpr size_t WS_WGU = 48 * MiB;
constexpr size_t WS_X1B = 176 * MiB;
constexpr size_t WS_WD = 304 * MiB;
constexpr size_t WS_XN = 432 * MiB;
constexpr size_t WS_PROJ = 560 * MiB;
constexpr size_t WS_Y = 880 * MiB;
constexpr size_t WS_PART = 368 * MiB;
constexpr size_t WS_MIX = 1008 * MiB;
constexpr size_t WS_END = 1136 * MiB;
constexpr int CW_BAR = 4096;
constexpr int CW_FLG = 65536;
constexpr int CW_Q = 12288;
constexpr int CW_CNT = 16384;

constexpr int RING_BYTES = 131072;
constexpr int LDSCTL_OFF = 143360;
constexpr int LDS_BYTES = 147456;
constexpr int MISC_OFF = LDSCTL_OFF;
constexpr int TAB_OFF = LDSCTL_OFF + 256;
constexpr int NWAVES = 8;

#define GAS __attribute__((address_space(1)))
#define LAS __attribute__((address_space(3)))
typedef unsigned short bf16;
typedef unsigned v4u __attribute__((ext_vector_type(4)));
typedef unsigned v2u __attribute__((ext_vector_type(2)));
typedef float f32x4 __attribute__((ext_vector_type(4)));
typedef float f32x2 __attribute__((ext_vector_type(2)));
typedef float f32x16 __attribute__((ext_vector_type(16)));
typedef short bf16x8 __attribute__((ext_vector_type(8)));
typedef __bf16 bf16x2_t __attribute__((ext_vector_type(2)));
typedef int v4i_t __attribute__((ext_vector_type(4)));
typedef int v8i_t __attribute__((ext_vector_type(8)));
typedef GAS unsigned gu32;
#define RLX_AGENT __ATOMIC_RELAXED, __HIP_MEMORY_SCOPE_AGENT
#define LDS_WAIT() asm volatile("s_waitcnt lgkmcnt(0)" ::: "memory")
#define VM_WAIT() asm volatile("s_waitcnt vmcnt(0)" ::: "memory")

__device__ __forceinline__ unsigned cvtpk(float lo, float hi) { f32x2 v = {lo, hi}; bf16x2_t b = __builtin_convertvector(v, bf16x2_t); return __builtin_bit_cast(unsigned, b); }
__device__ __forceinline__ float clamp448(float v) { return __builtin_fminf(__builtin_fmaxf(v, -448.f), 448.f); }
__device__ __forceinline__ unsigned cvt4_fp8(float a, float b, float c, float d) {
    int p = __builtin_amdgcn_cvt_pk_fp8_f32(clamp448(a), clamp448(b), 0, false); p = __builtin_amdgcn_cvt_pk_fp8_f32(clamp448(c), clamp448(d), p, true); return (unsigned)p; }
__device__ __forceinline__ float bf_lo(unsigned w) { return __builtin_bit_cast(float, w << 16); }
__device__ __forceinline__ float bf_hi(unsigned w) { return __builtin_bit_cast(float, w & 0xffff0000u); }
__device__ __forceinline__ float bf2f(bf16 b) { return __builtin_bit_cast(float, ((unsigned)b) << 16); }
__device__ __forceinline__ float fast_rcp(float x) { return __builtin_amdgcn_rcpf(x); }
__device__ __forceinline__ float fast_exp(float x) { return __builtin_amdgcn_exp2f(x * 1.44269504089f); }
__device__ __forceinline__ float fast_sqrt(float x) { return __builtin_amdgcn_sqrtf(x); }
__device__ __forceinline__ float fast_rsq(float x) { return __builtin_amdgcn_rsqf(x); }
__device__ __forceinline__ float sigmoidf_(float x) { return fast_rcp(1.0f + fast_exp(-x)); }
__device__ __forceinline__ float wave_sum(float v) {
#pragma unroll
    for (int o = 1; o < 64; o <<= 1) v += __shfl_xor(v, o);
    return v;
}

namespace pg8 {
constexpr int BM = 256, BK = 64, HALF = 128, HTB = HALF * BK * 2, STAGE_BYTES = 8 * HTB, NXCD = 8, WGM = 8;
constexpr int ROWTAB_OFF = STAGE_BYTES;
__host__ __device__ __forceinline__ int lds_byte(int r, int c) { const int st = (r >> 4) * 2 + (c >> 5), rr = r & 15, cc = c & 31, ob = rr * 64 + cc * 2; return st * 1024 + (ob ^ (((ob >> 9) & 1) << 5)); }
__host__ __device__ __forceinline__ void stage_rc(int b, int& R, int& C) { const int st = b / 1024, sb = b % 1024, swz = sb ^ (((sb >> 9) & 1) << 5); R = (st >> 1) * 16 + swz / 64; C = (st & 1) * 32 + (swz % 64) / 2; }
__host__ __device__ __forceinline__ int perm32(int rho) { const int n = rho >> 4, i = rho & 15; return 8 * (i >> 2) + 4 * n + (i & 3); }

struct Unit { int pm, pn, e, r0, cnt, nt; };
struct Gemm { const void* A; const void* Bt; int RB; };

struct StaticOrder {
    static constexpr bool UNIT_OFF = false;
    static constexpr bool GROUPED = false;
    int nM, nN, nwg, G, c;
    __device__ void init(int M_, int N_, int G_, int c_) { nM = M_ / BM; nN = N_ / BM; nwg = nM * nN; G = G_; c = c_; }
    __device__ __forceinline__ bool next(int i, Unit& u) const {
        const long L = (long)i * G + c; if (L >= nwg) return false;
        int wgid = (int)L; { const int q = nwg / NXCD, r = nwg % NXCD, xcd = wgid % NXCD, off = wgid / NXCD; wgid = (xcd < r ? xcd * (q + 1) : r * (q + 1) + (xcd - r) * q) + off; }
        const int nig = WGM * nN, gid = wgid / nig, fm = gid * WGM, gsz = (nM - fm) < WGM ? (nM - fm) : WGM;
        u.pm = fm + ((wgid % nig) % gsz); u.pn = (wgid % nig) / gsz; u.e = 0; u.r0 = 0; u.cnt = 0; u.nt = 0; return true;
    }
    __device__ __forceinline__ void a_off(const Unit&, const int (&R)[2], const int (&C)[2], int RB, unsigned (&o)[2][2]) const {
#pragma unroll
        for (int h = 0; h < 2; ++h)
#pragma unroll
            for (int i = 0; i < 2; ++i) o[h][i] = (unsigned)((h * HALF + R[i]) * RB + C[i] * 2);
    }
    __device__ __forceinline__ const char* a_base(const Gemm& g, const Unit& u) const { return (const char*)g.A + (size_t)u.pm * ((size_t)BM * g.RB); }
};
template <int NT, bool GATHER> struct GroupedOrder {
    static constexpr bool UNIT_OFF = GATHER;
    static constexpr bool GROUPED = true;
    const LAS int* tstart; const LAS int* texp; const int* ltok; const unsigned* cnt; int G, vcu;
    __device__ __forceinline__ bool next(int i, Unit& u) const {
        const int total = __builtin_amdgcn_readfirstlane(tstart[NE]) * NT;
        const int gx = G >> 3, x = vcu / gx, j = vcu % gx;
        const int per = (total + 7) >> 3, q = x * per + j + i * gx;
        if (j + i * gx >= per || q >= total) return false;
        const int mt = q / NT; u.nt = q % NT; u.pm = mt;
        const int e = __builtin_amdgcn_readfirstlane(texp[mt]); u.e = e; u.pn = e * NT + u.nt;
        u.r0 = (mt - __builtin_amdgcn_readfirstlane(tstart[e])) * BM;
        u.cnt = __builtin_amdgcn_readfirstlane(tstart[80 + MT_MAX + e]);
        return true;
    }
    __device__ __forceinline__ void a_off(const Unit& u, const int (&R)[2], const int (&C)[2], int RB, unsigned (&o)[2][2]) const {
#pragma unroll
        for (int h = 0; h < 2; ++h)
#pragma unroll
            for (int i = 0; i < 2; ++i) {
                if (GATHER) { const int rie = u.r0 + h * HALF + R[i]; const int tok = rie < u.cnt ? (ltok[(size_t)u.e * LISTCAP + rie] >> 1) : 0; o[h][i] = (unsigned)(tok * RB + C[i] * 2); }
                else o[h][i] = (unsigned)((h * HALF + R[i]) * RB + C[i] * 2);
            }
    }
    __device__ __forceinline__ const char* a_base(const Gemm& g, const Unit& u) const { return GATHER ? (const char*)g.A : (const char*)g.A + (size_t)u.pm * ((size_t)BM * g.RB); }
};

struct EpiBf16 {
    static constexpr bool PERM = true; static constexpr bool ROWTAB = false;
    bf16* O; int ldc;
    __device__ __forceinline__ void operator()(const f32x4 (&acc)[2][2][4][2], const Unit& u, int wr, int wc, int fr, int fq) const {
        const int row0 = u.pm * BM + wr * 64 + fr, col0 = u.pn * BM + wc * 32 + 8 * fq;
#pragma unroll
        for (int ai = 0; ai < 2; ++ai)
#pragma unroll
            for (int m = 0; m < 4; ++m) { bf16* rowp = O + (size_t)(row0 + ai * HALF + m * 16) * ldc + col0;
#pragma unroll
                for (int bj = 0; bj < 2; ++bj) { const f32x4 v0 = acc[ai][bj][m][0], v1 = acc[ai][bj][m][1];
                    v4u w; w.x = cvtpk(v0[0], v0[1]); w.y = cvtpk(v0[2], v0[3]); w.z = cvtpk(v1[0], v1[1]); w.w = cvtpk(v1[2], v1[3]);
                    *(v4u*)(rowp + bj * HALF) = w; } }
    }
};
struct EpiResid {
    static constexpr bool PERM = true; static constexpr bool ROWTAB = false;
    bf16* O; const float* x; const float* mod;
    __device__ __forceinline__ void operator()(const f32x4 (&acc)[2][2][4][2], const Unit& u, int wr, int wc, int fr, int fq) const {
        const int row0 = u.pm * BM + wr * 64 + fr, col0 = u.pn * BM + wc * 32 + 8 * fq;
        const float* gp = mod + (size_t)((u.pm * BM) / SEQ) * (6 * D) + 2 * D + col0;
        f32x4 g[2][2];
#pragma unroll
        for (int bj = 0; bj < 2; ++bj) { g[bj][0] = *(const f32x4*)(gp + bj * HALF); g[bj][1] = *(const f32x4*)(gp + bj * HALF + 4); }
#pragma unroll
        for (int ai = 0; ai < 2; ++ai) {
            const GAS float* xp = (const GAS float*)x + (size_t)(row0 + ai * HALF) * D + col0; GAS bf16* op = (GAS bf16*)O + (size_t)(row0 + ai * HALF) * D + col0;
            asm volatile("" : "+v"(xp), "+v"(op));
            f32x4 xv[4][2][2];
#pragma unroll
            for (int m = 0; m < 4; ++m)
#pragma unroll
                for (int bj = 0; bj < 2; ++bj) { xv[m][bj][0] = __builtin_nontemporal_load((const GAS f32x4*)(xp + (size_t)(m * 16) * D + bj * HALF)); xv[m][bj][1] = __builtin_nontemporal_load((const GAS f32x4*)(xp + (size_t)(m * 16) * D + bj * HALF + 4)); }
#pragma unroll
            for (int m = 0; m < 4; ++m)
#pragma unroll
                for (int bj = 0; bj < 2; ++bj) { const f32x4 v0 = xv[m][bj][0] + g[bj][0] * acc[ai][bj][m][0], v1 = xv[m][bj][1] + g[bj][1] * acc[ai][bj][m][1];
                    v4u w; w.x = cvtpk(v0[0], v0[1]); w.y = cvtpk(v0[2], v0[3]); w.z = cvtpk(v1[0], v1[1]); w.w = cvtpk(v1[2], v1[3]);
                    *(GAS v4u*)(op + (size_t)(m * 16) * D + bj * HALF) = w; }
        }
    }
};
struct EpiSwiGLU {
    static constexpr bool PERM = true; static constexpr bool ROWTAB = true;
    unsigned char* H; const float* lw;
    __device__ __forceinline__ const unsigned* rowtab(const Unit& u, int row) const { const int rie = u.r0 + row; return (const unsigned*)(lw + (size_t)u.e * LISTCAP + (rie < LISTCAP ? rie : LISTCAP - 1)); }
    __device__ __forceinline__ void operator()(const f32x4 (&acc)[2][2][4][2], const Unit& u, int wr, int wc, int fr, int fq, const LAS unsigned* tab) const {
        const int rt0 = wr * 64 + fr, col0 = u.nt * HALF + wc * 32 + 8 * fq;
        float wv[2][4];
#pragma unroll
        for (int ai = 0; ai < 2; ++ai)
#pragma unroll
            for (int m = 0; m < 4; ++m) { const int row = rt0 + ai * HALF + m * 16; wv[ai][m] = (u.r0 + row) < u.cnt ? __builtin_bit_cast(float, tab[row]) : 0.f; }
#pragma unroll
        for (int ai = 0; ai < 2; ++ai)
#pragma unroll
            for (int m = 0; m < 4; ++m) { unsigned char* rowp = H + (size_t)(u.pm * BM + rt0 + ai * HALF + m * 16) * DE + col0; const float sw = wv[ai][m];
                float h[8];
#pragma unroll
                for (int n = 0; n < 2; ++n)
#pragma unroll
                    for (int j = 0; j < 4; ++j) { const float g = acc[ai][0][m][n][j] * (1.0f / S_WGU), up = acc[ai][1][m][n][j] * (S_H / S_WGU); h[n * 4 + j] = g * sigmoidf_(g) * (up * sw); }
                v2u w; w.x = cvt4_fp8(h[0], h[1], h[2], h[3]); w.y = cvt4_fp8(h[4], h[5], h[6], h[7]);
                *(v2u*)rowp = w; }
    }
};
struct EpiF8G {
    static constexpr bool PERM = true; static constexpr bool ROWTAB = true;
    unsigned char* O; const int* ltok;
    __device__ __forceinline__ const unsigned* rowtab(const Unit& u, int row) const { const int rie = u.r0 + row; return (const unsigned*)(ltok + (size_t)u.e * LISTCAP + (rie < LISTCAP ? rie : LISTCAP - 1)); }
    __device__ __forceinline__ void operator()(const f32x4 (&acc)[2][2][4][2], const Unit& u, int wr, int wc, int fr, int fq, const LAS unsigned* tab) const {
        const int rt0 = wr * 64 + fr, col0 = u.nt * BM + wc * 32 + 8 * fq;
        constexpr float sc = S_Y / (S_H * S_WD);
#pragma unroll
        for (int ai = 0; ai < 2; ++ai) { int dr[4];
#pragma unroll
            for (int m = 0; m < 4; ++m) { const int row = rt0 + ai * HALF + m * 16; dr[m] = (u.r0 + row) < u.cnt ? (int)tab[row] : 2 * M; }
#pragma unroll
            for (int m = 0; m < 4; ++m) { unsigned char* rowp = O + (size_t)dr[m] * D + col0;
#pragma unroll
                for (int bj = 0; bj < 2; ++bj) { const f32x4 v0 = acc[ai][bj][m][0] * sc, v1 = acc[ai][bj][m][1] * sc;
                    v2u w; w.x = cvt4_fp8(v0[0], v0[1], v0[2], v0[3]); w.y = cvt4_fp8(v1[0], v1[1], v1[2], v1[3]);
                    *(v2u*)(rowp + bj * HALF) = w; } }
            asm volatile("" ::: "memory"); }
    }
};

template <class Epi, class Sched, bool ALIGN_EPI, bool F8 = false>
__device__ __forceinline__ void gemm_phase(LAS unsigned char* lds, const Gemm g, const Sched& S, const Epi& E) {
    const int tid = threadIdx.x, wid = __builtin_amdgcn_readfirstlane(tid >> 6), lane = tid & 63, wr = wid >> 2, wc = wid & 3, fr = lane & 15, fq = lane >> 4;
    const int K = g.RB, nt = K / (BK * 2);
    int Rr[2], Cc[2]; unsigned voffB[2];
#pragma unroll
    for (int i = 0; i < 2; ++i) { int R, C; stage_rc(tid * 16 + i * 8192, R, C); const int Rb = Epi::PERM ? ((R & ~31) + perm32(R & 31)) : R; Rr[i] = R; Cc[i] = C; voffB[i] = (unsigned)(Rb * K + C * 2); }
    const size_t kstep = (size_t)(BK * 2);
    const size_t hstep = (size_t)HALF * K;
    const size_t tstep = 2 * hstep;
    const unsigned ldsw = (unsigned)wid * 1024u;
    const int aoff = lds_byte(wr * 64 + fr, fq * 8), boff = lds_byte(wc * 32 + fr, fq * 8);
#define PG8_SA(b, h) (((b) * 2 + (h)) * HTB)
#define PG8_SB(b, h) ((4 + (b) * 2 + (h)) * HTB)
#define PG8_STAGE(bufoff, gbase, voff) do { _Pragma("unroll") for (int _i = 0; _i < 2; ++_i) \
        __builtin_amdgcn_global_load_lds((const unsigned*)((const char*)(gbase) + (voff)[_i]), (LAS unsigned*)(lds + (bufoff) + ldsw + _i * 8192), 16, 0, 0); } while (0)
#define PG8_LDA(dst, b, h) do { if constexpr (F8) { _Pragma("unroll") for (int m = 0; m < 4; ++m) dst##8[m] = __builtin_shufflevector(*(const LAS v4i_t*)(lds + PG8_SA(b, h) + aoff + m * 2048), *(const LAS v4i_t*)(lds + PG8_SA(b, h) + aoff + m * 2048 + 1024), 0, 1, 2, 3, 4, 5, 6, 7); } \
        else { _Pragma("unroll") for (int m = 0; m < 4; ++m) _Pragma("unroll") for (int k = 0; k < 2; ++k) dst[m][k] = *(const LAS bf16x8*)(lds + PG8_SA(b, h) + aoff + m * 2048 + k * 1024); } } while (0)
#define PG8_LDB(dst, b, h) do { if constexpr (F8) { _Pragma("unroll") for (int n = 0; n < 2; ++n) dst##8[n] = __builtin_shufflevector(*(const LAS v4i_t*)(lds + PG8_SB(b, h) + boff + n * 2048), *(const LAS v4i_t*)(lds + PG8_SB(b, h) + boff + n * 2048 + 1024), 0, 1, 2, 3, 4, 5, 6, 7); } \
        else { _Pragma("unroll") for (int n = 0; n < 2; ++n) _Pragma("unroll") for (int k = 0; k < 2; ++k) dst[n][k] = *(const LAS bf16x8*)(lds + PG8_SB(b, h) + boff + n * 2048 + k * 1024); } } while (0)
#define PG8_MMA(ai, bj, At, Bt) do { __builtin_amdgcn_s_setprio(1); _Pragma("unroll") for (int m = 0; m < 4; ++m) _Pragma("unroll") for (int n = 0; n < 2; ++n) { \
        if constexpr (F8) {   \
              \
            if (m == 0 && n == 0) asm volatile("s_nop 1\n\tv_mfma_scale_f32_16x16x128_f8f6f4 %0, %1, %2, %0, %3, %3 op_sel_hi:[0,0,0]" : "+v"(acc[ai][bj][m][n]) : "v"(Bt##8[n]), "v"(At##8[m]), "v"(sc1)); \
            else asm volatile("v_mfma_scale_f32_16x16x128_f8f6f4 %0, %1, %2, %0, %3, %3 op_sel_hi:[0,0,0]" : "+v"(acc[ai][bj][m][n]) : "v"(Bt##8[n]), "v"(At##8[m]), "v"(sc1)); \
        } else { _Pragma("unroll") for (int k = 0; k < 2; ++k) acc[ai][bj][m][n] = __builtin_amdgcn_mfma_f32_16x16x32_bf16(Bt[n][k], At[m][k], acc[ai][bj][m][n], 0, 0, 0); } } \
        __builtin_amdgcn_s_setprio(0); } while (0)
#define PG8_WAIT_V(n) asm volatile("s_waitcnt vmcnt(" #n ")" ::: "memory")
#define PG8_WAIT_L(n) asm volatile("s_waitcnt lgkmcnt(" #n ")" ::: "memory")
#define PG8_BAR __builtin_amdgcn_s_barrier()
#define PG8_SCHED __builtin_amdgcn_sched_barrier(0)
    Unit cur, nxt; int ui = 0;
    if (!S.next(0, cur)) return;
    f32x4 acc[2][2][4][2];
#pragma unroll
    for (int a = 0; a < 2; ++a)
#pragma unroll
        for (int b = 0; b < 2; ++b)
#pragma unroll
            for (int m = 0; m < 4; ++m)
#pragma unroll
                for (int n = 0; n < 2; ++n) acc[a][b][m][n] = (f32x4){0.f, 0.f, 0.f, 0.f};
    const int sc1 = 0x7f7f7f7f;
    bf16x8 At[4][2], B0[2][2], B1[2][2]; v8i_t At8[4], B08[2], B18[2];
    unsigned cO[2][2], nO[2][2];
    S.a_off(cur, Rr, Cc, K, cO);
    const char* cA = S.a_base(g, cur); const char* cB = (const char*)g.Bt + (size_t)cur.pn * tstep;
    PG8_STAGE(PG8_SB(0, 0), cB, voffB); PG8_STAGE(PG8_SB(0, 1), cB + hstep, voffB); PG8_STAGE(PG8_SA(0, 0), cA, cO[0]); PG8_STAGE(PG8_SA(0, 1), cA, cO[1]);
    if (wr == 1) PG8_BAR;
    PG8_WAIT_V(2); PG8_BAR;
    PG8_STAGE(PG8_SB(1, 0), cB + kstep, voffB); PG8_STAGE(PG8_SA(1, 0), cA + kstep, cO[0]); PG8_STAGE(PG8_SB(1, 1), cB + hstep + kstep, voffB);
    PG8_WAIT_V(6); PG8_BAR;
    for (;;) {
        if constexpr (Epi::ROWTAB) { if (wid < 4) __builtin_amdgcn_global_load_lds(E.rowtab(cur, wid * 64 + lane), (LAS unsigned*)(lds + ROWTAB_OFF + (ui & 1) * 1024 + wid * 256), 4, 0, 0); }
        const bool has_next = S.next(ui + 1, nxt);
        const char* nA = cA; const char* nB = cB;
        if constexpr (Sched::UNIT_OFF) {
#pragma unroll
            for (int h = 0; h < 2; ++h)
#pragma unroll
                for (int i = 0; i < 2; ++i) nO[h][i] = cO[h][i];
        }
        if (has_next) { if constexpr (Sched::UNIT_OFF) S.a_off(nxt, Rr, Cc, K, nO); nA = S.a_base(g, nxt); nB = (const char*)g.Bt + (size_t)nxt.pn * tstep; }
        const bool half_unit = Sched::GROUPED && (cur.cnt - cur.r0) <= HALF;
#pragma unroll 1
        for (int t = 0; t < nt; t += 2) {
            const bool last = (t == nt - 2);
            const char* a1 = cA + (size_t)(t + 1) * kstep;
            const char* a2 = last ? nA : cA + (size_t)(t + 2) * kstep; const char* b2 = last ? nB : cB + (size_t)(t + 2) * kstep;
            const char* a3 = a2 + kstep; const char* b3 = b2 + kstep;
            unsigned o2[2][2];
#pragma unroll
            for (int h = 0; h < 2; ++h)
#pragma unroll
                for (int i = 0; i < 2; ++i) o2[h][i] = (Sched::UNIT_OFF && last) ? nO[h][i] : cO[h][i];
            PG8_LDB(B0, 0, 0); PG8_LDB(B1, 0, 1); PG8_SCHED; PG8_LDA(At, 0, 0); PG8_STAGE(PG8_SA(1, 1), a1, cO[1]);
            PG8_WAIT_V(8); PG8_WAIT_L(0); PG8_BAR; PG8_MMA(0, 0, At, B0); PG8_MMA(0, 1, At, B1); PG8_BAR; PG8_SCHED;
            PG8_LDA(At, 0, 1); PG8_STAGE(PG8_SB(0, 0), b2, voffB); PG8_STAGE(PG8_SB(0, 1), b2 + hstep, voffB); PG8_STAGE(PG8_SA(0, 0), a2, o2[0]);
            PG8_WAIT_V(8); PG8_WAIT_L(0); PG8_BAR; if (!half_unit) { PG8_MMA(1, 0, At, B0); PG8_MMA(1, 1, At, B1); } PG8_BAR; PG8_SCHED;
            PG8_LDB(B0, 1, 0); PG8_LDB(B1, 1, 1); PG8_SCHED; PG8_LDA(At, 1, 0); PG8_STAGE(PG8_SA(0, 1), a2, o2[1]);
            PG8_WAIT_V(8); PG8_WAIT_L(0); PG8_BAR; PG8_MMA(0, 0, At, B0); PG8_MMA(0, 1, At, B1); PG8_BAR; PG8_SCHED;
            PG8_LDA(At, 1, 1); PG8_STAGE(PG8_SB(1, 0), b3, voffB); PG8_STAGE(PG8_SB(1, 1), b3 + hstep, voffB); PG8_STAGE(PG8_SA(1, 0), a3, o2[0]);
            PG8_WAIT_V(8); PG8_WAIT_L(0); PG8_BAR; if (!half_unit) { PG8_MMA(1, 0, At, B0); PG8_MMA(1, 1, At, B1); } PG8_BAR; PG8_SCHED;
        }
        if constexpr (ALIGN_EPI) { if (wr == 0) PG8_BAR; }
        if constexpr (F8) asm volatile("s_nop 15\n\ts_nop 7" ::: "memory");
        if constexpr (Epi::ROWTAB) E(acc, cur, wr, wc, fr, fq, (const LAS unsigned*)(lds + ROWTAB_OFF + (ui & 1) * 1024)); else E(acc, cur, wr, wc, fr, fq);
        if (!has_next) break;
#pragma unroll
        for (int a = 0; a < 2; ++a)
#pragma unroll
            for (int b = 0; b < 2; ++b)
#pragma unroll
                for (int m = 0; m < 4; ++m)
#pragma unroll
                    for (int n = 0; n < 2; ++n) acc[a][b][m][n] = (f32x4){0.f, 0.f, 0.f, 0.f};
        cur = nxt; cA = nA; cB = nB; ++ui;
        if constexpr (Sched::UNIT_OFF) {
#pragma unroll
            for (int h = 0; h < 2; ++h)
#pragma unroll
                for (int i = 0; i < 2; ++i) cO[h][i] = nO[h][i];
        }
        if constexpr (ALIGN_EPI) { if (wr == 1) PG8_BAR; }
    }
    PG8_WAIT_V(0);
    if constexpr (!ALIGN_EPI) { if (wr == 0) PG8_BAR; }
    PG8_BAR;
#undef PG8_SA
#undef PG8_SB
#undef PG8_STAGE
#undef PG8_LDA
#undef PG8_LDB
#undef PG8_MMA
#undef PG8_WAIT_V
#undef PG8_WAIT_L
#undef PG8_BAR
#undef PG8_SCHED
}
}

#define XB_TMO      128
#define XB_XCNT(j)  (256  + 64 * (j))
#define XB_XSUB(j)  (1280 + 64 * (j))
#define XB_XGEN(j)  (2304 + 64 * (j))
#define XB_TOP      3328
#define XB_TOPGEN   3392
#define XCD_BAR_WORDS 3456
#define XB_SPIN_CAP (1u << 18)
__device__ __forceinline__ unsigned xb_ld(unsigned* p)              { return __hip_atomic_load(p, __ATOMIC_RELAXED, __HIP_MEMORY_SCOPE_AGENT); }
__device__ __forceinline__ unsigned xb_add(unsigned* p, unsigned v) { return __hip_atomic_fetch_add(p, v, __ATOMIC_RELAXED, __HIP_MEMORY_SCOPE_AGENT); }
__device__ __forceinline__ unsigned xb_xcc_id() { return (unsigned)__builtin_amdgcn_s_getreg((3 << 11) | 20) & 0xFu; }
#define XB_SPIN(cond, bar) do { unsigned _sp = 0; while (cond) { __builtin_amdgcn_s_sleep(1); \
    if ((++_sp & 255u) == 0u) { if (xb_ld(&(bar)[XB_TMO])) break; if (_sp > XB_SPIN_CAP) { atomicAdd(&(bar)[XB_TMO], 1u); break; } } } } while (0)
struct XcdBarrier { unsigned* bar; unsigned x; volatile LAS unsigned* st; };
__device__ __forceinline__ XcdBarrier xcd_barrier_post(unsigned* bar, volatile LAS unsigned* st) {
    XcdBarrier b; b.bar = bar; b.x = xb_xcc_id(); b.st = st;
    if (threadIdx.x == 0) (void)xb_add(&bar[XB_XCNT(b.x)], 1u);
    return b;
}
__device__ __forceinline__ void xcd_barrier_complete(unsigned* bar, unsigned x, unsigned& nloc, unsigned& nx) {
    const unsigned G = gridDim.x * gridDim.y * gridDim.z;
    unsigned sum, cnt, mine, sp = 0u;
    for (;;) {
        sum = 0u; cnt = 0u; mine = 0u;
#pragma unroll
        for (unsigned j = 0; j < 16; ++j) { const unsigned c = xb_ld(&bar[XB_XCNT(j)]); sum += c; cnt += (c > 0u) ? 1u : 0u; mine = (j == x) ? c : mine; }
        if (sum == G) break;
        __builtin_amdgcn_s_sleep(1);
        if ((++sp & 255u) == 0u) { if (xb_ld(&bar[XB_TMO])) break; if (sp > XB_SPIN_CAP) { atomicAdd(&bar[XB_TMO], 1u); break; } }
    }
    nloc = mine > 0u ? mine : 1u; nx = cnt > 0u ? cnt : 1u;
}
__device__ __forceinline__ void xcd_barrier(const XcdBarrier& b) {
    asm volatile("s_waitcnt vmcnt(0)" ::: "memory");
    __syncthreads();
    if (threadIdx.x == 0) {
        unsigned* bar = b.bar;
        __builtin_amdgcn_s_waitcnt(0);
        unsigned nloc = b.st[0], nx = b.st[1];
        if (nloc == 0u) { xcd_barrier_complete(bar, b.x, nloc, nx); b.st[0] = nloc; b.st[1] = nx; }
        const unsigned old = xb_add(&bar[XB_XSUB(b.x)], 1u);
        const unsigned gen = old / nloc;
        if (old + 1u == (gen + 1u) * nloc) {
            __builtin_amdgcn_fence(__ATOMIC_RELEASE, "agent");
            asm volatile("s_waitcnt vmcnt(0)" ::: "memory");
            const unsigned og = xb_add(&bar[XB_TOP], 1u);
            const unsigned tg = og / nx;
            if (og + 1u == (tg + 1u) * nx) xb_add(&bar[XB_TOPGEN], 1u);
            else XB_SPIN(xb_ld(&bar[XB_TOPGEN]) == tg, bar);
            __builtin_amdgcn_fence(__ATOMIC_ACQUIRE, "agent");
            xb_add(&bar[XB_XGEN(b.x)], 1u);
            asm volatile("s_waitcnt vmcnt(0)" ::: "memory");
        } else {
            XB_SPIN(xb_ld(&bar[XB_XGEN(b.x)]) == gen, bar);
            __builtin_amdgcn_fence(__ATOMIC_ACQUIRE, "agent");
            asm volatile("s_waitcnt vmcnt(0)" ::: "memory");
        }
    }
    __syncthreads();
}

struct Frame {
    LAS unsigned char* lds;
    volatile LAS unsigned* MISC;
    gu32* ctl;
    int tid, lane, wave, vcu, G;
};
struct Args {
    const float* in[26]; float* out; unsigned char* ws; size_t xn_off; int ph_lo, ph_hi;
};

__device__ __forceinline__ void p0_transpose_item(const float* W, int N, int k0, int n0, bf16* WT, size_t drow0, int Kd, LAS float* scr, int lane) {
    const int lq = lane & 15, lk = lane >> 4;
#pragma unroll 8
    for (int i = 0; i < 16; ++i) { const int kk = 4 * i + lk; const f32x4 v = *(const f32x4*)(W + (size_t)(k0 + kk) * N + n0 + 4 * lq);
        LAS float* s = scr + kk * 65 + 4 * lq; s[0] = v.x; s[1] = v.y; s[2] = v.z; s[3] = v.w; }
    LDS_WAIT(); asm volatile("" ::: "memory");
    const int c = lane & 7;
#pragma unroll
    for (int j = 0; j < 8; ++j) { const int n = (lane >> 3) + 8 * j; const LAS float* s = scr + (8 * c) * 65 + n;
        v4u o; o.x = cvtpk(s[0 * 65], s[1 * 65]); o.y = cvtpk(s[2 * 65], s[3 * 65]); o.z = cvtpk(s[4 * 65], s[5 * 65]); o.w = cvtpk(s[6 * 65], s[7 * 65]);
        *(v4u*)(WT + (drow0 + n) * (size_t)Kd + k0 + 8 * c) = o; }
    LDS_WAIT(); asm volatile("" ::: "memory");
}
__device__ __forceinline__ void p0_transpose_item_f8(const float* W, int N, int k0, int n0, unsigned char* W8, size_t drow0, int Kd, float sc, LAS float* scr, int lane) {
    const int lq = lane & 15, lk = lane >> 4;
#pragma unroll 8
    for (int i = 0; i < 16; ++i) { const int kk = 4 * i + lk; const f32x4 v = *(const f32x4*)(W + (size_t)(k0 + kk) * N + n0 + 4 * lq);
        LAS float* s = scr + kk * 65 + 4 * lq; s[0] = v.x * sc; s[1] = v.y * sc; s[2] = v.z * sc; s[3] = v.w * sc; }
    LDS_WAIT(); asm volatile("" ::: "memory");
    const int c = lane & 3;
#pragma unroll
    for (int j = 0; j < 4; ++j) { const int n = (lane >> 2) + 16 * j; const LAS float* s = scr + (16 * c) * 65 + n;
        v4u o; o.x = cvt4_fp8(s[0 * 65], s[1 * 65], s[2 * 65], s[3 * 65]); o.y = cvt4_fp8(s[4 * 65], s[5 * 65], s[6 * 65], s[7 * 65]);
        o.z = cvt4_fp8(s[8 * 65], s[9 * 65], s[10 * 65], s[11 * 65]); o.w = cvt4_fp8(s[12 * 65], s[13 * 65], s[14 * 65], s[15 * 65]);
        *(v4u*)(W8 + (drow0 + n) * (size_t)Kd + k0 + 16 * c) = o; }
    LDS_WAIT(); asm volatile("" ::: "memory");
}
constexpr int P0_I_IN = (D / 64) * (DIN / 64), P0_I_OUT = (D / 64) * (D / 64), P0_NITEMS = P0_I_IN + P0_I_OUT, P0_SPARE_ITEMS = 1920;
struct TrItem { const float* src; bf16* dst; int N; };
__device__ __forceinline__ TrItem tr_item(int r, const float* w_in, const float* w_out, bf16* Win_t, bf16* Wout_t) {
    TrItem c;
    if (r < P0_I_IN) { const int nb = r % (DIN / 64), kb = r / (DIN / 64); c.src = w_in + (size_t)(kb * 64) * DIN + nb * 64; c.dst = Win_t + (size_t)(nb * 64) * D + kb * 64; c.N = DIN; }
    else { r -= P0_I_IN; const int nb = r % (D / 64), kb = r / (D / 64); c.src = w_out + (size_t)(kb * 64) * D + nb * 64; c.dst = Wout_t + (size_t)(nb * 64) * D + kb * 64; c.N = D; }
    return c;
}
__device__ __forceinline__ void tr_load(const TrItem& c, f32x4 (&v)[16], int lane) { const int lq = lane & 15, lk = lane >> 4;
#pragma unroll
    for (int i = 0; i < 16; ++i) v[i] = __builtin_nontemporal_load((const f32x4*)(c.src + (size_t)(16 * lk + i) * c.N + 4 * lq)); }
__device__ __forceinline__ void tr_store(const TrItem& c, const f32x4 (&v)[16], int lane) { const int lq = lane & 15, lk = lane >> 4;
    bf16* dp = c.dst + (size_t)(4 * lq) * D + 16 * lk;
#pragma unroll
    for (int j = 0; j < 4; ++j) { v4u o0, o1;
        o0.x = cvtpk(v[0][j], v[1][j]); o0.y = cvtpk(v[2][j], v[3][j]); o0.z = cvtpk(v[4][j], v[5][j]); o0.w = cvtpk(v[6][j], v[7][j]);
        o1.x = cvtpk(v[8][j], v[9][j]); o1.y = cvtpk(v[10][j], v[11][j]); o1.z = cvtpk(v[12][j], v[13][j]); o1.w = cvtpk(v[14][j], v[15][j]);
        *(v4u*)(dp + (size_t)j * D) = o0; *(v4u*)(dp + (size_t)j * D + 8) = o1; }
}
__device__ __forceinline__ void p0_copy_items(int lane, int first, int stride, int limit, const float* w_in, const float* w_out, bf16* Win_t, bf16* Wout_t) {
    if (first >= limit) return;
    f32x4 va[16], vb[16];
    TrItem ca = tr_item(first, w_in, w_out, Win_t, Wout_t), cb;
    tr_load(ca, va, lane);
#pragma unroll 1
    for (;;) {
        int nx = first + stride; const bool m1 = nx < limit;
        if (m1) { cb = tr_item(nx, w_in, w_out, Win_t, Wout_t); tr_load(cb, vb, lane); }
        tr_store(ca, va, lane);
        if (!m1) break;
        first = nx + stride; const bool m2 = first < limit;
        if (m2) { ca = tr_item(first, w_in, w_out, Win_t, Wout_t); tr_load(ca, va, lane); }
        tr_store(cb, vb, lane);
        if (!m2) break;
    }
}
constexpr int NCONV = 56;
struct CvItem { const float* W; int N, k0, n0, Kd; size_t drow0; float sc; unsigned char* dst; };
__device__ __forceinline__ CvItem cv_item(int it, const float* w_e_gate, const float* w_e_up, const float* w_e_down, unsigned char* Wgu8, unsigned char* Wd8) {
    CvItem c; const int pair = it >> 1, sub = it & 1, which = pair / (NE * 128), rr = pair % (NE * 128), e = rr >> 7, rem = rr & 127;
    if (which < 2) { const int nb = rem & 7, kb = (rem >> 3) * 2 + sub, n0 = nb * 64; c.W = (which ? w_e_up : w_e_gate) + (size_t)e * D * DE; c.N = DE; c.k0 = kb * 64; c.n0 = n0; c.Kd = D;
        c.drow0 = (size_t)e * 1024 + (n0 >> 7) * 256 + which * 128 + (n0 & 127); c.sc = S_WGU; c.dst = Wgu8; }
    else { const int nb = rem & 31, kb = (rem >> 5) * 2 + sub; c.W = w_e_down + (size_t)e * DE * D; c.N = D; c.k0 = kb * 64; c.n0 = nb * 64; c.Kd = DE; c.drow0 = (size_t)e * D + nb * 64; c.sc = S_WD; c.dst = Wd8; }
    return c;
}
__device__ __forceinline__ void cv_load(const CvItem& c, f32x4 (&v)[16], int lane) { const int lq = lane & 15, lk = lane >> 4;
#pragma unroll
    for (int i = 0; i < 16; ++i) v[i] = __builtin_nontemporal_load((const f32x4*)(c.W + (size_t)(c.k0 + 16 * lk + i) * c.N + c.n0 + 4 * lq)); }
__device__ __forceinline__ unsigned cv4(float a, float b, float cc, float d, float sc) {
    int p = __builtin_amdgcn_cvt_pk_fp8_f32(__builtin_amdgcn_fmed3f(a * sc, -448.f, 448.f), __builtin_amdgcn_fmed3f(b * sc, -448.f, 448.f), 0, false);
    p = __builtin_amdgcn_cvt_pk_fp8_f32(__builtin_amdgcn_fmed3f(cc * sc, -448.f, 448.f), __builtin_amdgcn_fmed3f(d * sc, -448.f, 448.f), p, true); return (unsigned)p; }
__device__ __forceinline__ void cv_store(const CvItem& c, const f32x4 (&v)[16], int lane) { const int lq = lane & 15, lk = lane >> 4;
    unsigned char* dp = c.dst + (c.drow0 + 4 * lq) * (size_t)c.Kd + c.k0 + 16 * lk;
#pragma unroll
    for (int j = 0; j < 4; ++j) { v4u o;
        o.x = cv4(v[0][j], v[1][j], v[2][j], v[3][j], c.sc); o.y = cv4(v[4][j], v[5][j], v[6][j], v[7][j], c.sc);
        o.z = cv4(v[8][j], v[9][j], v[10][j], v[11][j], c.sc); o.w = cv4(v[12][j], v[13][j], v[14][j], v[15][j], c.sc);
        __builtin_nontemporal_store(o, (v4u*)(dp + (size_t)j * c.Kd)); }
}
__device__ __forceinline__ void convert_experts(Frame& F, int cw, int ncw, const float* w_e_gate, const float* w_e_up, const float* w_e_down, unsigned char* Wgu8, unsigned char* Wd8) {
    constexpr int NPAIR = 3 * NE * 128;
    f32x4 va[16], vb[16];
    int pr = cw; if (pr >= NPAIR) return;
    CvItem ca = cv_item(2 * pr, w_e_gate, w_e_up, w_e_down, Wgu8, Wd8), cb;
    cv_load(ca, va, F.lane);
#pragma unroll 1
    for (;;) {
        cb = cv_item(2 * pr + 1, w_e_gate, w_e_up, w_e_down, Wgu8, Wd8); cv_load(cb, vb, F.lane);
        cv_store(ca, va, F.lane);
        const int nx = pr + ncw; const bool more = nx < NPAIR;
        if (more) { ca = cv_item(2 * nx, w_e_gate, w_e_up, w_e_down, Wgu8, Wd8); cv_load(ca, va, F.lane); }
        cv_store(cb, vb, F.lane);
        if (!more) break;
        pr = nx;
    }
}
__device__ __forceinline__ void p0_mod_unit(Frame& F, const float* c, const float* ada_w, const float* ada_b, float* mod, int unit) {
    const int n0 = unit * 64, lane = F.lane, w = F.wave, k0 = w * 256;
    LAS float* sc = (LAS float*)(F.lds + w * 16384);
    const GAS float* cp = (const GAS float*)c + k0 + lane; asm volatile("" : "+v"(cp));
#pragma unroll
    for (int b = 0; b < NB; ++b)
#pragma unroll
        for (int j = 0; j < 4; ++j) { const float v = cp[(size_t)b * D + 64 * j]; sc[(64 * j + lane) * 16 + b] = v * sigmoidf_(v); }
    LDS_WAIT(); asm volatile("" ::: "memory");
    float acc[NB][4];
#pragma unroll
    for (int b = 0; b < NB; ++b)
#pragma unroll
        for (int j = 0; j < 4; ++j) acc[b][j] = 0.f;
    const int lq = lane & 15, lk = lane >> 4;
    const GAS float* wp = (const GAS float*)ada_w + (size_t)(k0 + lk) * (6 * D) + n0 + 4 * lq;
    f32x4 wa[8];
#define P0_LOAD(u_, i0) wa[u_] = __builtin_nontemporal_load((const GAS f32x4*)(wp + (size_t)(4 * ((i0) + u_)) * (6 * D)))
#define P0_FMA(u_, i0) do { const LAS f32x4* sp = (const LAS f32x4*)(sc + (4 * ((i0) + u_) + lk) * 16); const f32x4 wv = wa[u_]; \
        _Pragma("unroll") for (int q = 0; q < 4; ++q) { const f32x4 s4 = sp[q]; \
            _Pragma("unroll") for (int bb = 0; bb < 4; ++bb) _Pragma("unroll") for (int j = 0; j < 4; ++j) acc[q * 4 + bb][j] += s4[bb] * wv[j]; } } while (0)
    asm volatile("" : "+v"(wp));
#pragma unroll
    for (int u = 0; u < 8; ++u) P0_LOAD(u, 0);
#pragma unroll 1
    for (int i0 = 0; i0 < 56; i0 += 8) {
        asm volatile("" : "+v"(wp));
#pragma unroll
        for (int u = 0; u < 8; ++u) { P0_FMA(u, i0); P0_LOAD(u, 8); __builtin_amdgcn_sched_barrier(0); }
        wp += (size_t)32 * (6 * D);
    }
#pragma unroll
    for (int u = 0; u < 8; ++u) { P0_FMA(u, 56); __builtin_amdgcn_sched_barrier(0); }
#undef P0_LOAD
#undef P0_FMA
    LDS_WAIT(); asm volatile("" ::: "memory");
    LAS f32x4* rp = (LAS f32x4*)(F.lds + w * 16384) + lane * 16;
#pragma unroll
    for (int b = 0; b < NB; ++b) rp[b] = (f32x4){acc[b][0], acc[b][1], acc[b][2], acc[b][3]};
    LDS_WAIT(); __syncthreads();
    for (int o = F.tid; o < NB * 64; o += NWAVES * 64) { const int b = o >> 6, n = o & 63, q = n >> 2, j = n & 3; float s = 0.f;
#pragma unroll
        for (int ww = 0; ww < 8; ++ww)
#pragma unroll
            for (int gq = 0; gq < 4; ++gq) s += ((const LAS float*)(F.lds + ww * 16384))[(gq * 16 + q) * 64 + b * 4 + j];
        mod[(size_t)b * (6 * D) + n0 + n] = s + ada_b[n0 + n]; }
    LDS_WAIT(); __syncthreads();
}

__device__ __forceinline__ void modnorm_rows(Frame& F, const float* xin, bf16* xn, const float* gain, const float* shift, const float* scale, int r0, int nrows) {
    int ln = F.lane; asm volatile("" : "+v"(ln));
    f32x4 mu[8], ad[8];
#pragma unroll
    for (int j = 0; j < 8; ++j) { const f32x4 g = ((const f32x4*)gain)[ln + 64 * j], sc = ((const f32x4*)scale)[ln + 64 * j]; mu[j] = g * (1.0f + sc); ad[j] = ((const f32x4*)shift)[ln + 64 * j]; }
    for (int r = r0; r < r0 + nrows; r += 2) {
        const f32x4* xr = (const f32x4*)(xin + (size_t)r * D) + ln;
        f32x4 v[2][8]; float s[2] = {0.f, 0.f};
#pragma unroll
        for (int q = 0; q < 2; ++q)
#pragma unroll
            for (int j = 0; j < 8; ++j) v[q][j] = xr[q * (D / 4) + 64 * j];
#pragma unroll
        for (int q = 0; q < 2; ++q) {
#pragma unroll
            for (int j = 0; j < 8; ++j) s[q] += (v[q][j].x * v[q][j].x + v[q][j].y * v[q][j].y) + (v[q][j].z * v[q][j].z + v[q][j].w * v[q][j].w);
            const float rstd = fast_rsq(wave_sum(s[q]) * (1.0f / D) + EPS);
            v2u* o8 = (v2u*)(xn + (size_t)(r + q) * D) + ln;
#pragma unroll
            for (int j = 0; j < 8; ++j) { const f32x4 h = v[q][j] * rstd * mu[j] + ad[j]; v2u w; w.x = cvtpk(h.x, h.y); w.y = cvtpk(h.z, h.w); o8[64 * j] = w; }
        }
    }
}

__device__ __forceinline__ float gelu_tanh(float x) {
    const float t = 1.5957691216f * (x + 0.044715f * x * x * x);
    return x * sigmoidf_(t);
}
template <int CTRL> __device__ __forceinline__ float dpp_f(float old, float src) {
    return __builtin_bit_cast(float, __builtin_amdgcn_update_dpp(__builtin_bit_cast(int, old), __builtin_bit_cast(int, src), CTRL, 0xf, 0xf, false)); }
__device__ __forceinline__ float row16_sum(float v) {
    v += dpp_f<0xB1>(0.f, v);
    v += dpp_f<0x4E>(0.f, v);
    v += dpp_f<0x141>(0.f, v);
    v += dpp_f<0x140>(0.f, v);
    return v;
}
constexpr int MB_TB = 128, MB_PITCH = 272;
constexpr int MB_XI = 0, MB_C4 = 2 * MB_TB * MB_PITCH, MB_RING = MB_C4 + 5 * 128 * 4, MB_RPITCH = 144, MB_RB = MB_TB * MB_RPITCH;
constexpr int MB_SSW = MB_RING + 3 * MB_RB, MB_END = MB_SSW + 3 * 4 * MB_TB * 4;
static_assert(MB_END <= LDSCTL_OFF, "mixer LDS");
__device__ __forceinline__ void p3_unit(Frame& F, const bf16* proj, bf16* Y, float* PART, const float* conv3_w, const float* gconv, const float* conv4_w, const float* conv4_b, const float* lru_w_a, const float* lru_b_a,
                                        const float* lru_w_x, const float* lru_b_x, const float* lam, const float* glru, int unit) {
    const int b = unit >> 4, hd = (unit >> 1) & 7, half = unit & 1, lane = F.lane, w = F.wave, c = lane & 15, kg = lane >> 4;
    const bool isB = w < 4;
    LAS float* C4 = (LAS float*)(F.lds + MB_C4);
    __syncthreads();
    for (int idx = F.tid; idx < 5 * 128; idx += NWAVES * 64) { const int tap = idx >> 7, ch = idx & 127; C4[idx] = tap < 4 ? conv4_w[tap * DL + hd * 128 + ch] : conv4_b[hd * 128 + ch]; }
    const int pc = F.tid & 15, tg = F.tid >> 4;
    LAS unsigned char* xi_w = F.lds + MB_XI + (4 * tg) * MB_PITCH + pc * 16;
    LAS unsigned char* c4l = F.lds + MB_C4 + pc * 32;
    const bf16* xb = proj + (size_t)b * SEQ * DIN + 4 * 1024 + hd * 128 + pc * 8;
    const int cb = half * 64 + 16 * (w & 3), kx = cb >> 5;
    bf16x8 fa[4], fx[4], idn;
    float nba[4], nbx[4], nsp2[4], hfin[4];
    const bf16* gb = proj + (size_t)b * SEQ * DIN + 3 * 1024 + hd * 128 + 32 * kx + 8 * kg;
    LAS unsigned char* ring_w = F.lds + MB_RING + c * MB_RPITCH + (16 * (w & 3) + 4 * kg) * 2;
    LAS float* ssw_w = (LAS float*)(F.lds + MB_SSW) + (w & 3) * MB_TB + c;
    const int aw = w & 3;
#define P3_PUBLISH(blk) do { int la_ = lane, aw_ = aw; asm volatile("" : "+v"(la_), "+s"(aw_)); const LAS float* sw_ = (const LAS float*)(F.lds + MB_SSW) + ((blk) % 3) * 4 * MB_TB + 32 * aw_ + (la_ & 31); \
        const float own_ = (sw_[0] + sw_[MB_TB]) + (sw_[2 * MB_TB] + sw_[3 * MB_TB]); \
        if (la_ < 32) __hip_atomic_store(PART + ((size_t)unit * 16 + (blk)) * MB_TB + 32 * aw_ + la_, own_, RLX_AGENT); \
        asm volatile("s_waitcnt vmcnt(0)" ::: "memory"); \
        if (la_ == 0) __hip_atomic_store((unsigned*)(F.ctl + CW_FLG) + (unit * 16 + (blk)) * 4 + aw_, 1u, RLX_AGENT); } while (0)
#define P3_NORMALISE(blk) do { int la_ = lane, aw_ = aw; asm volatile("" : "+v"(la_), "+s"(aw_)); { unsigned* fo_ = (unsigned*)(F.ctl + CW_FLG) + ((unit ^ 1) * 16 + (blk)) * 4 + aw_; unsigned sp_ = 0; \
          while (__builtin_amdgcn_readfirstlane(__hip_atomic_load(fo_, RLX_AGENT)) == 0u) { if (++sp_ > (1u << 20)) break; __builtin_amdgcn_s_sleep(2); } } \
        const LAS float* sw_ = (const LAS float*)(F.lds + MB_SSW) + ((blk) % 3) * 4 * MB_TB + 32 * aw_ + (la_ & 31); \
        const float tot_ = ((sw_[0] + sw_[MB_TB]) + (sw_[2 * MB_TB] + sw_[3 * MB_TB])) + __hip_atomic_load(PART + ((size_t)(unit ^ 1) * 16 + (blk)) * MB_TB + 32 * aw_ + (la_ & 31), RLX_AGENT); \
        const float rs_ = fast_rsq(tot_ * (1.0f / LRU_HD) + EPS); \
        float gl8[8]; { const f32x4* gp_ = (const f32x4*)(glru + hd * 128 + half * 64 + (la_ & 7) * 8); const f32x4 ga_ = gp_[0], gb_ = gp_[1]; \
            gl8[0] = ga_.x; gl8[1] = ga_.y; gl8[2] = ga_.z; gl8[3] = ga_.w; gl8[4] = gb_.x; gl8[5] = gb_.y; gl8[6] = gb_.z; gl8[7] = gb_.w; } \
        bf16* ynorm = Y + (size_t)b * SEQ * D + DC + hd * 128 + half * 64 + (la_ & 7) * 8; \
        _Pragma("unroll") for (int i_ = 0; i_ < 4; ++i_) { const int tl_ = (la_ >> 3) + 8 * i_; const float r_ = __shfl(rs_, tl_); \
            const v4u p_ = *(const LAS v4u*)(F.lds + MB_RING + ((blk) % 3) * MB_RB + (32 * aw_ + tl_) * MB_RPITCH + (la_ & 7) * 16); \
            v4u o_; o_.x = cvtpk(bf_lo(p_.x) * r_ * gl8[0], bf_hi(p_.x) * r_ * gl8[1]); o_.y = cvtpk(bf_lo(p_.y) * r_ * gl8[2], bf_hi(p_.y) * r_ * gl8[3]); \
            o_.z = cvtpk(bf_lo(p_.z) * r_ * gl8[4], bf_hi(p_.z) * r_ * gl8[5]); o_.w = cvtpk(bf_lo(p_.w) * r_ * gl8[6], bf_hi(p_.w) * r_ * gl8[7]); \
            *(v4u*)(ynorm + (size_t)((blk) * MB_TB + 32 * aw_ + tl_) * D) = o_; } } while (0)
    LAS unsigned char* xi_r = F.lds + MB_XI + c * MB_PITCH + kg * 16;
    const int ach0 = (w & 1) * 512 + lane * 8, at0 = unit * 128 + ((w >> 1) & 1) * 64;
    float u1[8], u2[8];
    if (isB) {
#pragma unroll
        for (int ks = 0; ks < 4; ++ks) { float ta[8], tx[8];
#pragma unroll
            for (int j = 0; j < 8; ++j) { const size_t o = (size_t)hd * 16384 + (size_t)(32 * ks + 8 * kg + j) * 128 + cb + c; ta[j] = lru_w_a[o]; tx[j] = lru_w_x[o]; }
            v4u pa, px; pa.x = cvtpk(ta[0], ta[1]); pa.y = cvtpk(ta[2], ta[3]); pa.z = cvtpk(ta[4], ta[5]); pa.w = cvtpk(ta[6], ta[7]);
            px.x = cvtpk(tx[0], tx[1]); px.y = cvtpk(tx[2], tx[3]); px.z = cvtpk(tx[4], tx[5]); px.w = cvtpk(tx[6], tx[7]);
            fa[ks] = __builtin_bit_cast(bf16x8, pa); fx[ks] = __builtin_bit_cast(bf16x8, px); }
#pragma unroll
        for (int j = 0; j < 8; ++j) idn[j] = (8 * kg + j == (cb & 31) + c) ? (short)0x3f80 : (short)0;
#pragma unroll
        for (int r = 0; r < 4; ++r) { const int ch = hd * 128 + cb + 4 * kg + r; nba[r] = -1.44269504089f * lru_b_a[ch]; nbx[r] = -1.44269504089f * lru_b_x[ch];
            nsp2[r] = -8.0f * 1.44269504089f * log1pf(expf(-lam[ch])); hfin[r] = 0.f; }
    } else {
        v4u c1 = {0, 0, 0, 0}, x1 = {0, 0, 0, 0}, c2 = {0, 0, 0, 0}, x2 = {0, 0, 0, 0};
        if ((at0 % SEQ) != 0) { const bf16* p1 = proj + (size_t)(at0 - 1) * DIN + ach0; const bf16* p2 = proj + (size_t)(at0 - 2) * DIN + ach0;
            c1 = *(const v4u*)(p1 + DC); x1 = *(const v4u*)(p1 + 2 * DC); c2 = *(const v4u*)(p2 + DC); x2 = *(const v4u*)(p2 + 2 * DC); }
#pragma unroll
        for (int q = 0; q < 4; ++q) { u1[2 * q] = bf_lo(c1[q]) * bf_lo(x1[q]); u1[2 * q + 1] = bf_hi(c1[q]) * bf_hi(x1[q]); u2[2 * q] = bf_lo(c2[q]) * bf_lo(x2[q]); u2[2 * q + 1] = bf_hi(c2[q]) * bf_hi(x2[q]); }
    }
    asm volatile("" : "+v"(xi_w), "+v"(xi_r), "+v"(c4l));
    LDS_WAIT(); __syncthreads();
    v4u rows[7];
#pragma unroll
    for (int i = 0; i < 7; ++i) { const int tt = 4 * tg - 3 + i; rows[i] = (v4u){0, 0, 0, 0}; if (tt >= 0) rows[i] = *(const v4u*)(xb + (size_t)tt * DIN); }
    bf16x8 gq0 = {0, 0, 0, 0, 0, 0, 0, 0}, gq1 = gq0;
    if (isB) { gq0 = *(const bf16x8*)(gb + (size_t)c * DIN); gq1 = *(const bf16x8*)(gb + (size_t)(16 + c) * DIN); }
#pragma unroll 1
    for (int tb = 0; tb < SEQ / MB_TB; ++tb) {
        const int t0 = tb * MB_TB, bufo = (tb & 1) * (MB_TB * MB_PITCH);
        {
            float wt[4][8], bs[8];
#pragma unroll
            for (int tap = 0; tap < 4; ++tap) { const LAS f32x4* wp = (const LAS f32x4*)(c4l + tap * 512); const f32x4 wa = wp[0], wb = wp[1];
                wt[tap][0] = wa.x; wt[tap][1] = wa.y; wt[tap][2] = wa.z; wt[tap][3] = wa.w; wt[tap][4] = wb.x; wt[tap][5] = wb.y; wt[tap][6] = wb.z; wt[tap][7] = wb.w; }
            { const LAS f32x4* wp = (const LAS f32x4*)(c4l + 4 * 512); const f32x4 wa = wp[0], wb = wp[1]; bs[0] = wa.x; bs[1] = wa.y; bs[2] = wa.z; bs[3] = wa.w; bs[4] = wb.x; bs[5] = wb.y; bs[6] = wb.z; bs[7] = wb.w; }
#pragma unroll
            for (int i = 0; i < 4; ++i) { float xc[8];
#pragma unroll
                for (int j = 0; j < 8; ++j) xc[j] = bs[j];
#pragma unroll
                for (int tap = 0; tap < 4; ++tap) { const v4u v = rows[i + tap];
                    xc[0] += wt[tap][0] * bf_lo(v.x); xc[1] += wt[tap][1] * bf_hi(v.x); xc[2] += wt[tap][2] * bf_lo(v.y); xc[3] += wt[tap][3] * bf_hi(v.y);
                    xc[4] += wt[tap][4] * bf_lo(v.z); xc[5] += wt[tap][5] * bf_hi(v.z); xc[6] += wt[tap][6] * bf_lo(v.w); xc[7] += wt[tap][7] * bf_hi(v.w); }
                v4u p; p.x = cvtpk(xc[0], xc[1]); p.y = cvtpk(xc[2], xc[3]); p.z = cvtpk(xc[4], xc[5]); p.w = cvtpk(xc[6], xc[7]);
                *(LAS v4u*)(xi_w + bufo + i * MB_PITCH) = p; }
        }
        LDS_WAIT(); __syncthreads();
        if (tb + 1 < SEQ / MB_TB) {
#pragma unroll
            for (int i = 0; i < 7; ++i) rows[i] = *(const v4u*)(xb + (size_t)(t0 + MB_TB + 4 * tg - 3 + i) * DIN);
        }
        if (isB) {
#pragma unroll 1
            for (int s = 0; s < MB_TB / 16; ++s) {
                const bf16x8 gfr = gq0; gq0 = gq1;
                { int tn = t0 + 16 * (s + 2) + c; tn = tn < SEQ ? tn : SEQ - 1; gq1 = *(const bf16x8*)(gb + (size_t)tn * DIN); }
                f32x4 ar = {0.f, 0.f, 0.f, 0.f}, ai = ar, ax = ar, ag = ar;
                const LAS unsigned char* xr = xi_r + bufo + s * (16 * MB_PITCH);
#pragma unroll
                for (int ks = 0; ks < 4; ++ks) { const bf16x8 xf = *(const LAS bf16x8*)(xr + ks * 64);
                    ar = __builtin_amdgcn_mfma_f32_16x16x32_bf16(fa[ks], xf, ar, 0, 0, 0);
                    ai = __builtin_amdgcn_mfma_f32_16x16x32_bf16(fx[ks], xf, ai, 0, 0, 0); }
                { const bf16x8 xf = *(const LAS bf16x8*)(xr + kx * 64); ax = __builtin_amdgcn_mfma_f32_16x16x32_bf16(idn, xf, ax, 0, 0, 0); }
                ag = __builtin_amdgcn_mfma_f32_16x16x32_bf16(idn, gfr, ag, 0, 0, 0);
                float yv[4], Hs[4], Ps[4];
#pragma unroll
                for (int r = 0; r < 4; ++r) {
                    const float rg = fast_rcp(1.0f + __builtin_amdgcn_exp2f(ar[r] * -1.44269504089f + nba[r]));
                    const float ig = fast_rcp(1.0f + __builtin_amdgcn_exp2f(ai[r] * -1.44269504089f + nbx[r]));
                    const float la2 = nsp2[r] * rg;
                    const float a = __builtin_amdgcn_exp2f(la2), z = la2 * 1.38629436112f;
                    const float em1 = z * (1.0f + z * (0.5f + z * (0.16666667f + z * (0.041666668f + z * 0.0083333333f))));
                    const float om = (z > -0.35f) ? -em1 : 1.0f - a * a;
                    const float u = fast_sqrt(om) * ig * ax[r];
                    const float hp = dpp_f<0x121>(0.f, hfin[r]);
                    Hs[r] = (c == 0) ? a * hp + u : u; Ps[r] = a;
                }
#define SC_LVL(d) "v_fmac_f32_dpp %0, %0, %4 row_shr:" #d " row_mask:0xf bank_mask:0xf\n\tv_fmac_f32_dpp %1, %1, %5 row_shr:" #d " row_mask:0xf bank_mask:0xf\n\t" \
                  "v_fmac_f32_dpp %2, %2, %6 row_shr:" #d " row_mask:0xf bank_mask:0xf\n\tv_fmac_f32_dpp %3, %3, %7 row_shr:" #d " row_mask:0xf bank_mask:0xf\n\t"
#define SC_PRD(d) "v_mul_f32_dpp %4, %4, %4 row_shr:" #d " row_mask:0xf bank_mask:0xf\n\tv_mul_f32_dpp %5, %5, %5 row_shr:" #d " row_mask:0xf bank_mask:0xf\n\t" \
                  "v_mul_f32_dpp %6, %6, %6 row_shr:" #d " row_mask:0xf bank_mask:0xf\n\tv_mul_f32_dpp %7, %7, %7 row_shr:" #d " row_mask:0xf bank_mask:0xf\n\t"
                asm volatile("s_nop 1\n\t" SC_LVL(1) SC_PRD(1) SC_LVL(2) SC_PRD(2) SC_LVL(4) SC_PRD(4) SC_LVL(8) "s_nop 0"
                             : "+v"(Hs[0]), "+v"(Hs[1]), "+v"(Hs[2]), "+v"(Hs[3]), "+v"(Ps[0]), "+v"(Ps[1]), "+v"(Ps[2]), "+v"(Ps[3]));
#undef SC_LVL
#undef SC_PRD
#pragma unroll
                for (int r = 0; r < 4; ++r) { hfin[r] = Hs[r]; yv[r] = Hs[r] * gelu_tanh(ag[r]); }
                v2u o; o.x = cvtpk(yv[0], yv[1]); o.y = cvtpk(yv[2], yv[3]);
                *(LAS v2u*)(ring_w + (tb % 3) * MB_RB + s * (16 * MB_RPITCH)) = o;
                float q2 = (yv[0] * yv[0] + yv[1] * yv[1]) + (yv[2] * yv[2] + yv[3] * yv[3]);
                q2 += __shfl_xor(q2, 16); q2 += __shfl_xor(q2, 32);
                if (kg == 0) ssw_w[(tb % 3) * 4 * MB_TB + 16 * s] = q2;
            }
        } else {
            if (tb >= 1) P3_PUBLISH(tb - 1);
            if (tb >= 2) P3_NORMALISE(tb - 2);
            float w0[8], w1[8], w2[8], gg[8];
            { const f32x4* p0 = (const f32x4*)(conv3_w + ach0); const f32x4* p1 = (const f32x4*)(conv3_w + DC + ach0); const f32x4* p2 = (const f32x4*)(conv3_w + 2 * DC + ach0); const f32x4* pg = (const f32x4*)(gconv + ach0);
#pragma unroll
              for (int h = 0; h < 2; ++h) { const f32x4 a0 = p0[h], a1 = p1[h], a2 = p2[h], ag4 = pg[h];
#pragma unroll
                  for (int j = 0; j < 4; ++j) { w0[4 * h + j] = a0[j]; w1[4 * h + j] = a1[j]; w2[4 * h + j] = a2[j]; gg[4 * h + j] = ag4[j]; } } }
#pragma unroll
            for (int tt = 0; tt < 4; ++tt) { const int t = at0 + tb * 4 + tt;
                const bf16* p = proj + (size_t)t * DIN + ach0;
                const v4u bv = *(const v4u*)p, cv = *(const v4u*)(p + DC), xv = *(const v4u*)(p + 2 * DC);
                float y[8]; float ss = 0.f;
#pragma unroll
                for (int q = 0; q < 4; ++q) {
                    const float ua0 = bf_lo(cv[q]) * bf_lo(xv[q]), ub0 = bf_hi(cv[q]) * bf_hi(xv[q]);
                    const float va = w0[2 * q] * u2[2 * q] + w1[2 * q] * u1[2 * q] + w2[2 * q] * ua0;
                    const float vb = w0[2 * q + 1] * u2[2 * q + 1] + w1[2 * q + 1] * u1[2 * q + 1] + w2[2 * q + 1] * ub0;
                    u2[2 * q] = u1[2 * q]; u1[2 * q] = ua0; u2[2 * q + 1] = u1[2 * q + 1]; u1[2 * q + 1] = ub0;
                    y[2 * q] = bf_lo(bv[q]) * va; y[2 * q + 1] = bf_hi(bv[q]) * vb;
                    ss += y[2 * q] * y[2 * q] + y[2 * q + 1] * y[2 * q + 1];
                }
                ss += dpp_f<0xB1>(0.f, ss); ss += dpp_f<0x4E>(0.f, ss); ss += dpp_f<0x141>(0.f, ss);
                const float rstd = fast_rsq(ss * (1.0f / CONV_HD) + EPS);
                v4u o;
#pragma unroll
                for (int q = 0; q < 4; ++q) o[q] = cvtpk(y[2 * q] * rstd * gg[2 * q], y[2 * q + 1] * rstd * gg[2 * q + 1]);
                *(v4u*)(Y + (size_t)t * D + ach0) = o;
            }
        }
    }
    LDS_WAIT(); __syncthreads();
    if (!isB) { P3_PUBLISH(SEQ / MB_TB - 1); P3_NORMALISE(SEQ / MB_TB - 2); P3_NORMALISE(SEQ / MB_TB - 1); }
#undef P3_PUBLISH
#undef P3_NORMALISE
    __syncthreads();
}
__device__ __forceinline__ void p3b_rows(Frame& F, const bf16* YRAW, bf16* Y, const float* glru, int r0, int nrows) {
    float g[2][8];
#pragma unroll
    for (int i = 0; i < 2; ++i)
#pragma unroll
        for (int j = 0; j < 8; ++j) g[i][j] = glru[(F.lane + 64 * i) * 8 + j];
#pragma unroll 4
    for (int r = r0; r < r0 + nrows; ++r) { v4u* yr = (v4u*)(Y + (size_t)r * D + DC) + F.lane; const v4u* ys = (const v4u*)(YRAW + (size_t)r * DL) + F.lane;
#pragma unroll
        for (int i = 0; i < 2; ++i) { const v4u p = ys[64 * i];
            float v[8] = {bf_lo(p.x), bf_hi(p.x), bf_lo(p.y), bf_hi(p.y), bf_lo(p.z), bf_hi(p.z), bf_lo(p.w), bf_hi(p.w)};
            float ss = 0.f;
#pragma unroll
            for (int j = 0; j < 8; ++j) ss += v[j] * v[j];
            const float rstd = fast_rsq(row16_sum(ss) * (1.0f / LRU_HD) + EPS);
            v4u o; o.x = cvtpk(v[0] * rstd * g[i][0], v[1] * rstd * g[i][1]); o.y = cvtpk(v[2] * rstd * g[i][2], v[3] * rstd * g[i][3]);
            o.z = cvtpk(v[4] * rstd * g[i][4], v[5] * rstd * g[i][5]); o.w = cvtpk(v[6] * rstd * g[i][6], v[7] * rstd * g[i][7]);
            yr[64 * i] = o; } }
}

constexpr int P5_ROWB = 4112, P5_SLOT = 16, P5_IMG = P5_SLOT * P5_ROWB;
constexpr int P5_PSB = 4 * P5_SLOT * NRC * 4;
constexpr int P5_DEC_OFF = 2 * P5_IMG;
static_assert(P5_DEC_OFF + 4096 <= LDSCTL_OFF && P5_PSB + P5_SLOT * 72 * 4 <= P5_IMG, "P5 LDS");
#define P5_BAR() do { asm volatile("s_waitcnt lgkmcnt(0)" ::: "memory"); __builtin_amdgcn_s_barrier(); asm volatile("" ::: "memory"); } while (0)
struct P5Row { v2u m[8]; };
__device__ __forceinline__ void p5_issue(P5Row& R, const bf16* x1b, int r, int lane) {
    const v2u* mr = (const v2u*)(x1b + (size_t)r * D) + lane;
#pragma unroll
    for (int j = 0; j < 8; ++j) R.m[j] = mr[64 * j];
}
__device__ __forceinline__ void p5_row(const P5Row& R, const f32x4 (&mu)[8], const f32x4 (&ad)[8], unsigned char* xn, int r, LAS unsigned char* img_row, int lane) {
    f32x4 xv[8]; float s = 0.f;
#pragma unroll
    for (int j = 0; j < 8; ++j) { const v2u m2 = R.m[j];
        xv[j] = (f32x4){bf_lo(m2.x), bf_hi(m2.x), bf_lo(m2.y), bf_hi(m2.y)}; s += (xv[j].x * xv[j].x + xv[j].y * xv[j].y) + (xv[j].z * xv[j].z + xv[j].w * xv[j].w); }
    s = row16_sum(s);
    { const int si = __builtin_bit_cast(int, s);
      s = (__builtin_bit_cast(float, __builtin_amdgcn_readlane(si, 0)) + __builtin_bit_cast(float, __builtin_amdgcn_readlane(si, 16))) + (__builtin_bit_cast(float, __builtin_amdgcn_readlane(si, 32)) + __builtin_bit_cast(float, __builtin_amdgcn_readlane(si, 48))); }
    const float rstd = fast_rsq(s * (1.0f / D) + EPS);
    unsigned* o8 = (unsigned*)(xn + (size_t)r * D) + lane;
#pragma unroll
    for (int j = 0; j < 8; ++j) {
        const f32x4 h = xv[j] * rstd * mu[j] + ad[j]; v2u hi; hi.x = cvtpk(h.x, h.y); hi.y = cvtpk(h.z, h.w);
        o8[64 * j] = cvt4_fp8(h.x, h.y, h.z, h.w);
        *(LAS v2u*)(img_row + (lane + 64 * j) * 8) = hi; }
}
__device__ __forceinline__ void p5_group(Frame& F, const float* mb, const float* norm2_g, unsigned char* xn, const bf16* x1b, const bf16* wr_hi,
                                         const float* rbg, const float* rbe, int row0, int* ltok, float* lwt) {
    int lane = F.lane; asm volatile("" : "+v"(lane));
    const int w = F.wave; constexpr int NSL = 128 / P5_SLOT;
    LAS int* DEC_E = (LAS int*)(F.lds + P5_DEC_OFF); LAS float* DEC_W = (LAS float*)(F.lds + P5_DEC_OFF + 1024); LAS int* DEC_LP = (LAS int*)(F.lds + P5_DEC_OFF + 2048);
    LAS unsigned* LCNT = (LAS unsigned*)(F.lds + P5_DEC_OFF + 3072); LAS unsigned* GBASE = (LAS unsigned*)(F.lds + P5_DEC_OFF + 3328);
    LAS float* RBE = (LAS float*)(F.lds + P5_DEC_OFF + 3584); LAS float* RBG = (LAS float*)(F.lds + P5_DEC_OFF + 3840);
    int tid = F.tid; asm volatile("" : "+v"(tid));
    if (tid < 64) { LCNT[tid] = 0u; RBE[tid] = rbe[tid]; if (tid < 8) RBG[tid] = rbg[tid]; }
    LDS_WAIT(); __syncthreads();
    if (w < 4) {
        f32x4 mu[8], ad[8];
        { const GAS f32x4* pg = (const GAS f32x4*)norm2_g + lane; const GAS f32x4* pm = (const GAS f32x4*)mb + lane;
#pragma unroll
          for (int j = 0; j < 8; ++j) { if (j == 4) asm volatile("" : "+v"(pg), "+v"(pm));
              const f32x4 g = pg[64 * j], sc = pm[4 * (D / 4) + 64 * j]; mu[j] = g * (1.0f + sc); ad[j] = pm[3 * (D / 4) + 64 * j]; } }
        P5Row R0, R1, R2, R3;
        { const int r = row0 + 4 * w; p5_issue(R0, x1b, r, lane); p5_issue(R1, x1b, r + 1, lane); p5_issue(R2, x1b, r + 2, lane); p5_issue(R3, x1b, r + 3, lane); }
#pragma unroll 1
        for (int sl = 0; sl < NSL; ++sl) {
            LAS unsigned char* ibw = F.lds + (sl & 1) * P5_IMG + (4 * w) * P5_ROWB;
            const int rb = row0 + sl * P5_SLOT + 4 * w, nrb = sl + 1 < NSL ? rb + P5_SLOT : rb;
            p5_row(R0, mu, ad, xn, rb, ibw, lane); p5_issue(R0, x1b, nrb, lane);
            p5_row(R1, mu, ad, xn, rb + 1, ibw + P5_ROWB, lane); p5_issue(R1, x1b, nrb + 1, lane);
            P5_BAR();
            p5_row(R2, mu, ad, xn, rb + 2, ibw + 2 * P5_ROWB, lane); p5_issue(R2, x1b, nrb + 2, lane);
            P5_BAR();
            p5_row(R3, mu, ad, xn, rb + 3, ibw + 3 * P5_ROWB, lane); p5_issue(R3, x1b, nrb + 3, lane);
            P5_BAR();
        }
        P5_BAR(); P5_BAR(); P5_BAR();
    } else {
        const int cw = w & 3, fr = lane & 15, fq = lane >> 4;
        f32x4 acc[5];
        const GAS char* wbs = (const GAS char*)wr_hi + (size_t)cw * (5 * 16 * 1024); const unsigned lo16 = (unsigned)lane * 16u;
        bf16x8 bres[16][2];
        { const GAS char* wq = wbs; asm volatile("" : "+s"(wq));
#pragma unroll
          for (int ks = 0; ks < 16; ++ks) { bres[ks][0] = *(const GAS bf16x8*)(wq + ks * 1024 + lo16); bres[ks][1] = *(const GAS bf16x8*)(wq + (16 + ks) * 1024 + lo16); } }
        bf16x8 bw[12];
#define P5_BPTR(p_) (wq + (16 * (2 + (p_) % 3) + (p_) / 3) * 1024 + lo16)
        { const GAS char* wq = wbs; asm volatile("" : "+s"(wq));
#pragma unroll
          for (int p = 0; p < 12; ++p) bw[p] = *(const GAS bf16x8*)P5_BPTR(p); }
        P5_BAR(); P5_BAR(); P5_BAR();
#pragma unroll 1
        for (int sl = 1; sl <= NSL; ++sl) {
            LAS unsigned char* ibr = F.lds + ((sl + 1) & 1) * P5_IMG;
            {
#pragma unroll
                for (int t = 0; t < 5; ++t) acc[t] = (f32x4){0.f, 0.f, 0.f, 0.f};
                const GAS char* wq = wbs;
                const LAS unsigned char* ap = ibr + fr * P5_ROWB + (cw * 512 + 8 * fq) * 2;
                asm volatile("" : "+s"(wq), "+v"(ap));
                bf16x8 av[2]; av[0] = *(const LAS bf16x8*)ap;
#pragma unroll
                for (int ks = 0; ks < 16; ++ks) {
                    if (ks + 1 < 16) av[(ks + 1) & 1] = *(const LAS bf16x8*)(ap + (ks + 1) * 64);
                    const bf16x8 a0 = av[ks & 1];
                    acc[0] = __builtin_amdgcn_mfma_f32_16x16x32_bf16(a0, bres[ks][0], acc[0], 0, 0, 0);
                    acc[1] = __builtin_amdgcn_mfma_f32_16x16x32_bf16(a0, bres[ks][1], acc[1], 0, 0, 0);
#pragma unroll
                    for (int t3 = 0; t3 < 3; ++t3) { const int p = ks * 3 + t3;
                        acc[2 + t3] = __builtin_amdgcn_mfma_f32_16x16x32_bf16(a0, bw[p % 12], acc[2 + t3], 0, 0, 0);
                        bw[p % 12] = *(const GAS bf16x8*)P5_BPTR((p + 12) % 48); }
                    __builtin_amdgcn_sched_barrier(0); }
            }
            P5_BAR();
            { LAS float* PS = (LAS float*)ibr;
#pragma unroll
                for (int t = 0; t < 5; ++t)
#pragma unroll
                    for (int j = 0; j < 4; ++j) PS[(cw * P5_SLOT + fq * 4 + j) * NRC + t * 16 + fr] = acc[t][j]; }
            P5_BAR();
            if (cw == 0 && lane < P5_SLOT) { const LAS float* PS = (const LAS float*)ibr; const int lr = lane;
                f32x4 ga = {0.f, 0.f, 0.f, 0.f}, gb = ga;
#pragma unroll
                for (int ww = 0; ww < 4; ++ww) { const LAS f32x4* q = (const LAS f32x4*)(PS + (ww * P5_SLOT + lr) * NRC); ga += q[0]; gb += q[1]; }
                float gl_[8] = {ga.x, ga.y, ga.z, ga.w, gb.x, gb.y, gb.z, gb.w}; float mx = -3.0e38f; int gi = 0;
#pragma unroll
                for (int c = 0; c < 8; ++c) { gl_[c] += RBG[c]; if (gl_[c] > mx) { mx = gl_[c]; gi = c; } }
                float den = 0.f;
#pragma unroll
                for (int c = 0; c < 8; ++c) den += fast_exp(gl_[c] - mx);
                const float pg = fast_rcp(den);
                f32x4 ea = {0.f, 0.f, 0.f, 0.f}, eb = ea;
#pragma unroll
                for (int ww = 0; ww < 4; ++ww) { const LAS f32x4* q = (const LAS f32x4*)(PS + (ww * P5_SLOT + lr) * NRC + 8 + gi * 8); ea += q[0]; eb += q[1]; }
                const f32x4 ra = *(const LAS f32x4*)(RBE + gi * 8), rb4 = *(const LAS f32x4*)(RBE + gi * 8 + 4);
                const float le_[8] = {ea.x + ra.x, ea.y + ra.y, ea.z + ra.z, ea.w + ra.w, eb.x + rb4.x, eb.y + rb4.y, eb.z + rb4.z, eb.w + rb4.w};
                float v0 = -3.0e38f, v1 = -3.0e38f; int i0 = 0, i1 = 0;
#pragma unroll
                for (int e = 0; e < 8; ++e) { const float le = le_[e]; const bool b0 = le > v0, b1 = le > v1;
                    v1 = b0 ? v0 : (b1 ? le : v1); i1 = b0 ? i0 : (b1 ? e : i1); v0 = b0 ? le : v0; i0 = b0 ? e : i0; }
                const float ex = fast_exp(v1 - v0), rq = fast_rcp(1.0f + ex), w0 = pg * rq, w1 = pg * ex * rq;
                const int e0 = gi * 8 + i0, e1 = gi * 8 + i1, di = 2 * ((sl - 1) * P5_SLOT + lr);
                DEC_LP[di] = (int)__hip_atomic_fetch_add(LCNT + e0, 1u, __ATOMIC_RELAXED, __HIP_MEMORY_SCOPE_WORKGROUP); DEC_LP[di + 1] = (int)__hip_atomic_fetch_add(LCNT + e1, 1u, __ATOMIC_RELAXED, __HIP_MEMORY_SCOPE_WORKGROUP);
                DEC_E[di] = e0; DEC_E[di + 1] = e1; DEC_W[di] = w0; DEC_W[di + 1] = w1;
            }
            P5_BAR();
        }
    }
    asm volatile("" : "+v"(tid));
    if (tid < 64) { const unsigned c = LCNT[tid]; unsigned base = 0u; if (c) base = __hip_atomic_fetch_add((unsigned*)(F.ctl + CW_CNT + 64 * tid), c, RLX_AGENT); GBASE[tid] = base; }
    LDS_WAIT(); __syncthreads();
    if (tid < 256) { const int e = DEC_E[tid]; const size_t pos = (size_t)e * LISTCAP + GBASE[e] + (unsigned)DEC_LP[tid];
        ltok[pos] = 2 * (row0 + (tid >> 1)) + (tid & 1); lwt[pos] = DEC_W[tid]; }
}

__device__ __forceinline__ void build_tables(Frame& F) {
    LAS int* tstart = (LAS int*)(F.lds + TAB_OFF); LAS int* texp = tstart + 80;
    __syncthreads();
    if (F.tid < 64) {
        const unsigned c = __hip_atomic_load((unsigned*)(F.ctl + CW_CNT + 64 * F.tid), RLX_AGENT);
        int tl = (int)((c + 255u) >> 8), incl = tl;
#pragma unroll
        for (int o = 1; o < 64; o <<= 1) { const int t = __shfl_up(incl, o); if (F.lane >= o) incl += t; }
        tstart[F.tid + 1] = incl; if (F.tid == 0) tstart[0] = 0; tstart[80 + MT_MAX + F.tid] = (int)c;
    }
    LDS_WAIT(); __syncthreads();
    for (int mt = F.tid; mt < MT_MAX; mt += NWAVES * 64) { int e = 0;
        for (int j = 1; j < NE; ++j) e += (tstart[j] <= mt) ? 1 : 0;
        texp[mt] = e; }
    LDS_WAIT(); __syncthreads();
}

constexpr int N_PHASES = 10;
__global__ void __launch_bounds__(NWAVES * 64, 2) hybrid_fwd(Args args) {
    extern __shared__ __attribute__((aligned(16))) unsigned char lds[];
    Frame F;
    F.lds = (LAS unsigned char*)lds;
    F.MISC = (volatile LAS unsigned*)(F.lds + MISC_OFF);
    F.tid = threadIdx.x; F.lane = F.tid & 63; F.wave = __builtin_amdgcn_readfirstlane(F.tid >> 6);
    F.G = gridDim.x; { const int bx = blockIdx.x; F.vcu = (F.G % 8 == 0) ? (bx % 8) * (F.G / 8) + bx / 8 : bx; }
    unsigned char* ws = args.ws;
    F.ctl = (gu32*)(ws + WS_CTL);
    const float* x = args.in[0]; const float* cvec = args.in[1]; const float* ada_w = args.in[2]; const float* ada_b = args.in[3]; const float* norm1_g = args.in[4];
    const float* w_in = args.in[5]; const float* conv3_w = args.in[6]; const float* conv4_w = args.in[7]; const float* conv4_b = args.in[8];
    const float* lru_w_a = args.in[9]; const float* lru_b_a = args.in[10]; const float* lru_w_x = args.in[11]; const float* lru_b_x = args.in[12]; const float* lru_lambda = args.in[13];
    const float* hn_conv_g = args.in[14]; const float* hn_lru_g = args.in[15]; const float* w_out = args.in[16]; const float* norm2_g = args.in[17];
    const float* rwg = args.in[18]; const float* rbg = args.in[19]; const float* rwe = args.in[20]; const float* rbe = args.in[21];
    const float* w_e_gate = args.in[22]; const float* w_e_up = args.in[23]; const float* w_e_down = args.in[24]; const float* final_g = args.in[25];
    float* out = args.out;
    float* mod = (float*)(ws + WS_MOD);
    bf16* wr_hi = (bf16*)(ws + WS_WR);
    int* ltok = (int*)(ws + WS_LTOK); float* lwt = (float*)(ws + WS_LW);
    bf16* Win_t = (bf16*)(ws + WS_WIN); bf16* Wout_t = (bf16*)(ws + WS_WOUT); unsigned char* Wgu8 = ws + WS_WGU; unsigned char* Wd8 = ws + WS_WD;
    bf16* XN = (bf16*)(ws + args.xn_off); bf16* PROJ = (bf16*)(ws + WS_PROJ); bf16* YE = (bf16*)(ws + WS_PROJ); bf16* Y = (bf16*)(ws + WS_Y); unsigned char* HB = ws + WS_Y; bf16* MIX = (bf16*)(ws + WS_MIX); bf16* X1B = (bf16*)(ws + WS_X1B); bf16* YRAW = (bf16*)(ws + args.xn_off);

    for (int u = F.tid; u < (LDS_BYTES - LDSCTL_OFF) / 4; u += NWAVES * 64) ((LAS unsigned*)(F.lds + LDSCTL_OFF))[u] = 0u;
    __syncthreads();
    XcdBarrier bar; bar.bar = (unsigned*)(F.ctl + CW_BAR); bar.x = 0; bar.st = nullptr;
    if (MK_N_LAUNCHES == 1) bar = xcd_barrier_post((unsigned*)(F.ctl + CW_BAR), F.MISC + 8);
    const int lo = args.ph_lo, hi = args.ph_hi;
#ifndef PHASE_MASK
#define PHASE_MASK 0x3ff
#endif
#define IN(k) (((PHASE_MASK >> (k)) & 1) && lo <= (k) && (k) < hi)
#define SEAM(k) do { if (IN(k) && IN((k) + 1)) xcd_barrier(bar); } while (0)
    const int gw = F.vcu * NWAVES + F.wave, NGW = F.G * NWAVES;

    if (IN(0)) {
        for (int u = blockIdx.x; u < (6 * D) / 64; u += F.G) p0_mod_unit(F, cvec, ada_w, ada_b, mod, u);
        for (int idx = blockIdx.x * (NWAVES * 64) + F.tid; idx < NRC * D; idx += F.G * NWAVES * 64) {
            const int j = idx & 7, ln = (idx >> 3) & 63, ks = (idx >> 9) & 15, ct = idx >> 13, t = ct % 5, cwk = ct / 5;
            const int n = 16 * t + (ln & 15), k = 512 * cwk + 32 * ks + 8 * (ln >> 4) + j;
            const float v = n < 8 ? rwg[k * 8 + n] : (n < 72 ? rwe[(size_t)((n - 8) >> 3) * D * 8 + k * 8 + ((n - 8) & 7)] : 0.f);
            wr_hi[idx] = (bf16)(cvtpk(v, 0.f) & 0xffffu); }
        constexpr int NMODU = (6 * D) / 64;
        if (F.G > NMODU + 8) {
            if ((int)blockIdx.x >= NMODU) p0_copy_items(F.lane, ((int)blockIdx.x - NMODU) * NWAVES + F.wave, (F.G - NMODU) * NWAVES, P0_SPARE_ITEMS, w_in, w_out, Win_t, Wout_t);
            else p0_copy_items(F.lane, P0_SPARE_ITEMS + (int)blockIdx.x * NWAVES + F.wave, NMODU * NWAVES, P0_NITEMS, w_in, w_out, Win_t, Wout_t);
        } else p0_copy_items(F.lane, gw, NGW, P0_NITEMS, w_in, w_out, Win_t, Wout_t);
    }
    SEAM(0);
    if (IN(1)) {
        for (int grp = gw; grp < M / 16; grp += NGW) { const int r0 = grp * 16, b = r0 / SEQ; const float* mb = mod + (size_t)b * (6 * D);
            modnorm_rows(F, x, XN, norm1_g, mb, mb + D, r0, 16); }
    }
    SEAM(1);
    if (IN(2)) {
        if (F.G > 2 * NCONV && (int)blockIdx.x < NCONV) convert_experts(F, (int)blockIdx.x * NWAVES + F.wave, NCONV * NWAVES, w_e_gate, w_e_up, w_e_down, Wgu8, Wd8);
        else { const bool split = F.G > 2 * NCONV;
            if (!split) convert_experts(F, gw, NGW, w_e_gate, w_e_up, w_e_down, Wgu8, Wd8);
            pg8::Gemm g{XN, Win_t, 2 * D}; pg8::StaticOrder S; S.init(M, DIN, split ? F.G - NCONV : F.G, split ? (int)blockIdx.x - NCONV : (int)blockIdx.x);
            pg8::EpiBf16 E{PROJ, DIN};
            pg8::gemm_phase<pg8::EpiBf16, pg8::StaticOrder, true>(F.lds, g, S, E); }
    }
    SEAM(2);
    if (IN(3)) {
        for (int u = blockIdx.x; u < 256; u += F.G) p3_unit(F, PROJ, Y, (float*)(ws + WS_PART), conv3_w, hn_conv_g, conv4_w, conv4_b, lru_w_a, lru_b_a, lru_w_x, lru_b_x, lru_lambda, hn_lru_g, u);
    }
    SEAM(3);
    if (IN(5)) {
        pg8::Gemm g{Y, Wout_t, 2 * D}; pg8::StaticOrder S; S.init(M, D, F.G, (int)blockIdx.x);
        pg8::EpiResid E{X1B, x, mod};
        pg8::gemm_phase<pg8::EpiResid, pg8::StaticOrder, true>(F.lds, g, S, E);
    }
    SEAM(5);
    if (IN(6)) {
        for (int grp = blockIdx.x; grp < M / 128; grp += F.G) { const int b = (grp * 128) / SEQ; const float* mb = mod + (size_t)b * (6 * D);
            p5_group(F, mb, norm2_g, (unsigned char*)XN, X1B, wr_hi, rbg, rbe, grp * 128, ltok, lwt);
            __syncthreads();
        }
    }
    SEAM(6);
    if (IN(7)) {
        build_tables(F);
        pg8::Gemm g{XN, Wgu8, D};
        pg8::GroupedOrder<4, true> S{(const LAS int*)(F.lds + TAB_OFF), (const LAS int*)(F.lds + TAB_OFF) + 80, ltok, (const unsigned*)(F.ctl + CW_CNT), F.G, F.vcu};
        pg8::EpiSwiGLU E{HB, lwt};
        pg8::gemm_phase<pg8::EpiSwiGLU, pg8::GroupedOrder<4, true>, true, true>(F.lds, g, S, E);
    }
    SEAM(7);
    if (IN(8)) {
        build_tables(F);
        pg8::Gemm g{HB, Wd8, DE};
        pg8::GroupedOrder<8, false> S{(const LAS int*)(F.lds + TAB_OFF), (const LAS int*)(F.lds + TAB_OFF) + 80, ltok, (const unsigned*)(F.ctl + CW_CNT), F.G, F.vcu};
        pg8::EpiF8G E{(unsigned char*)YE, ltok};
        pg8::gemm_phase<pg8::EpiF8G, pg8::GroupedOrder<8, false>, true, true>(F.lds, g, S, E);
    }
    SEAM(8);
    if (IN(9)) {
        int ln = F.lane; asm volatile("" : "+v"(ln));
        const unsigned char* YE8 = (const unsigned char*)YE;
        for (int grp = gw; grp < M / 16; grp += NGW) { const int r0 = grp * 16, b = r0 / SEQ; const float* g2 = mod + (size_t)b * (6 * D) + 5 * D;
            f32x4 gg[8], fg[8];
#pragma unroll
            for (int j = 0; j < 8; ++j) { gg[j] = ((const f32x4*)g2)[ln + 64 * j] * (1.0f / S_Y); fg[j] = ((const f32x4*)final_g)[ln + 64 * j]; }
            for (int r = r0; r < r0 + 16; ++r) {
                const unsigned* y0 = (const unsigned*)(YE8 + (size_t)(2 * r) * D) + ln; const unsigned* y1 = y0 + D / 4;
                f32x4* xr = (f32x4*)(out + (size_t)r * D) + ln; const v2u* x1r = (const v2u*)(X1B + (size_t)r * D) + ln;
                f32x4 v[8]; float s = 0.f;
#pragma unroll
                for (int j = 0; j < 8; ++j) { const unsigned a = y0[64 * j], c = y1[64 * j]; const v2u xb = x1r[64 * j];
                    const f32x2 a0 = __builtin_amdgcn_cvt_pk_f32_fp8((int)a, false), a1 = __builtin_amdgcn_cvt_pk_f32_fp8((int)a, true), c0 = __builtin_amdgcn_cvt_pk_f32_fp8((int)c, false), c1 = __builtin_amdgcn_cvt_pk_f32_fp8((int)c, true);
                    const f32x4 xv = {bf_lo(xb.x), bf_hi(xb.x), bf_lo(xb.y), bf_hi(xb.y)};
                    const f32x4 ys = {a0.x + c0.x, a0.y + c0.y, a1.x + c1.x, a1.y + c1.y};
                    v[j] = xv + gg[j] * ys; s += (v[j].x * v[j].x + v[j].y * v[j].y) + (v[j].z * v[j].z + v[j].w * v[j].w); }
                const float rstd = fast_rsq(wave_sum(s) * (1.0f / D) + EPS);
#pragma unroll
                for (int j = 0; j < 8; ++j) xr[64 * j] = v[j] * rstd * fg[j];
            }
        }
    }
#undef IN
#undef SEAM
}

extern "C" void kernel_launch(void* const* d_in, const int* in_sizes, int n_in, void* d_out, int out_size, void* d_ws, size_t ws_size, hipStream_t stream) {
    static int grid = 0;
    if (grid == 0) {
        if (n_in != 26 || in_sizes[0] != M * D || out_size != M * D || ws_size < WS_END) { fprintf(stderr, "kernel_launch: unexpected shapes (n_in %d, in0 %d, out %d, ws %zu < %zu); nothing launched\n", n_in, n_in > 0 ? in_sizes[0] : -1, out_size, ws_size, (size_t)WS_END); grid = -1; return; }
        int dev = 0, cus = 0, per_cu = 0;
        if (hipGetDevice(&dev) != hipSuccess || hipDeviceGetAttribute(&cus, hipDeviceAttributeMultiprocessorCount, dev) != hipSuccess) { fprintf(stderr, "kernel_launch: device query failed\n"); grid = -1; return; }
        if (hipFuncSetAttribute((const void*)hybrid_fwd, hipFuncAttributeMaxDynamicSharedMemorySize, LDS_BYTES) != hipSuccess) { fprintf(stderr, "kernel_launch: hipFuncSetAttribute failed\n"); grid = -1; return; }
        if (hipOccupancyMaxActiveBlocksPerMultiprocessor(&per_cu, (const void*)hybrid_fwd, NWAVES * 64, LDS_BYTES) != hipSuccess || per_cu < 1) { fprintf(stderr, "kernel_launch: occupancy query reports %d workgroups per CU\n", per_cu); }
        (void)hipGetLastError();
        grid = cus;
        if (grid % 8 != 0 || grid < 8) { fprintf(stderr, "kernel_launch: grid %d not a multiple of 8\n", grid); grid = -1; return; }
    }
    if (grid < 0) return;
    if (hipMemsetAsync((char*)d_ws + WS_CTL, 0, CTL_ZERO_BYTES, stream) != hipSuccess) { fprintf(stderr, "kernel_launch: memset failed\n"); return; }
    Args a{};
    for (int i = 0; i < 26; ++i) a.in[i] = (const float*)d_in[i];
    a.out = (float*)d_out; a.ws = (unsigned char*)d_ws;
    a.xn_off = ws_size >= WS_END + 128 * MiB ? ((ws_size - 128 * MiB) & ~(size_t)(2 * MiB - 1)) : WS_XN;
    for (int li = 0; li < (MK_N_LAUNCHES == 1 ? 1 : N_PHASES); ++li) {
        a.ph_lo = (MK_N_LAUNCHES == 1) ? 0 : li; a.ph_hi = (MK_N_LAUNCHES == 1) ? N_PHASES : li + 1;
        hipLaunchKernelGGL(hybrid_fwd, dim3(grid), dim3(NWAVES * 64), LDS_BYTES, stream, a);
        const hipError_t le = hipPeekAtLastError();
        if (le != hipSuccess) { fprintf(stderr, "kernel_launch: launch %d failed: %s\n", li, hipGetErrorName(le)); break; }
    }
}
```
